# Optimizing an MI355X kernel written in HIP

```python
import math
import jax, jax.numpy as jnp
from jax import lax
import numpy as np

D_MODEL = 1024
BATCH = 2
SEQ = 8192
DEPTH = 1

D_MIX = D_MODEL
CONV_CH = D_MIX // 2
CONV_GROUPS = 8
N_HEADS = 8
HEAD_DIM = 64
ATT_CH = N_HEADS * HEAD_DIM
CONV_WIDTH = 31
GRID_W = 64
MAX_KH = 8
KW = 16
EPS = 1e-6
PROJ_OUT = 3 * CONV_CH + 4 * ATT_CH

kernel_name = "hybrid_conformer_conv_natten_block"


def rms_norm(x, g):
    x32 = x.astype(jnp.float32)
    y = x32 * lax.rsqrt(jnp.mean(x32 * x32, axis=-1, keepdims=True) + EPS)
    return (y * g.astype(jnp.float32)).astype(x.dtype)


def layer_norm(x, g, b):
    x32 = x.astype(jnp.float32)
    mu = jnp.mean(x32, axis=-1, keepdims=True)
    var = jnp.mean(jnp.square(x32 - mu), axis=-1, keepdims=True)
    y = (x32 - mu) * lax.rsqrt(var + EPS)
    return (y * g.astype(jnp.float32) + b.astype(jnp.float32)).astype(x.dtype)


def grouped_rms_norm(y, g, n_groups):
    B, T, C = y.shape
    y32 = y.astype(jnp.float32).reshape(B, T, n_groups, C // n_groups)
    y32 = y32 * lax.rsqrt(jnp.mean(y32 * y32, axis=-1, keepdims=True) + EPS)
    return (y32.reshape(B, T, C) * g.astype(jnp.float32)).astype(y.dtype)


def conformer_conv(glu_a, glu_b, dw_w, dw_b, cln_g, cln_b, pw_w, pw_b):
    u = glu_a * jax.nn.sigmoid(glu_b)
    pad = CONV_WIDTH // 2
    u = lax.conv_general_dilated(
        u, dw_w[:, None, :].astype(u.dtype), window_strides=(1,),
        padding=[(pad, pad)], dimension_numbers=("NWC", "WIO", "NWC"),
        feature_group_count=u.shape[-1]) + dw_b
    u = layer_norm(u, cln_g, cln_b)
    u = jax.nn.silu(u)
    return u @ pw_w + pw_b


def neighbourhood_attention(q, k, v, rpb):
    B, T, _ = q.shape
    rows = T // GRID_W
    kh = min(MAX_KH, rows)

    def to_grid(t):
        return t.reshape(B, rows, GRID_W, N_HEADS, HEAD_DIM).transpose(0, 3, 1, 2, 4)

    qg, kg, vg = to_grid(q), to_grid(k), to_grid(v)
    scale = HEAD_DIM ** -0.5

    row_ids = jnp.arange(rows)
    row_start = jnp.clip(row_ids - kh // 2, 0, rows - kh)
    col_ids = jnp.arange(GRID_W)
    col_start = jnp.clip(col_ids - KW // 2, 0, GRID_W - KW)
    col_idx = col_start[:, None] + jnp.arange(KW)[None, :]
    col_rel = col_idx - col_ids[:, None] + (KW - 1)

    def one_row(args):
        r, rs = args
        q_row = lax.dynamic_index_in_dim(qg, r, axis=2, keepdims=False)
        k_rows = lax.dynamic_slice_in_dim(kg, rs, kh, axis=2)
        v_rows = lax.dynamic_slice_in_dim(vg, rs, kh, axis=2)
        k_win = k_rows[:, :, :, col_idx, :]
        v_win = v_rows[:, :, :, col_idx, :]
        s = jnp.einsum("bhwd,bhiwjd->bhwij", q_row, k_win).astype(jnp.float32) * scale
        row_rel = rs + jnp.arange(kh) - r + (MAX_KH - 1)
        bias = rpb[:, row_rel[:, None, None], col_rel[None, :, :]]
        s = s + bias.transpose(0, 2, 1, 3).astype(jnp.float32)[None]
        p = jax.nn.softmax(s.reshape(B, N_HEADS, GRID_W, kh * KW), axis=-1)
        p = p.reshape(B, N_HEADS, GRID_W, kh, KW).astype(v.dtype)
        return jnp.einsum("bhwij,bhiwjd->bhwd", p, v_win)

    out = lax.map(one_row, (row_ids, row_start))
    return out.transpose(1, 0, 3, 2, 4).reshape(B, T, ATT_CH)


def setup_inputs(seed: int = 0) -> dict:
    key = jax.random.key(seed)
    ks = jax.random.split(key, 16)
    f32 = jnp.float32
    nrm = lambda k, s: jax.random.normal(k, s, f32)
    return {
        "x": nrm(ks[0], (BATCH, SEQ, D_MODEL)),
        "ln_g": 1.0 + 0.01 * nrm(ks[1], (DEPTH, D_MODEL)),
        "w_in": nrm(ks[2], (DEPTH, D_MODEL, PROJ_OUT)) * D_MODEL ** -0.5,
        "b_in": 0.01 * nrm(ks[3], (DEPTH, PROJ_OUT)),
        "dw_w": nrm(ks[4], (DEPTH, CONV_WIDTH, CONV_CH)) * CONV_WIDTH ** -0.5,
        "dw_b": 0.01 * nrm(ks[5], (DEPTH, CONV_CH)),
        "cln_g": 1.0 + 0.01 * nrm(ks[6], (DEPTH, CONV_CH)),
        "cln_b": 0.01 * nrm(ks[7], (DEPTH, CONV_CH)),
        "pw_w": nrm(ks[8], (DEPTH, CONV_CH, CONV_CH)) * CONV_CH ** -0.5,
        "pw_b": 0.01 * nrm(ks[9], (DEPTH, CONV_CH)),
        "rpb": 0.02 * nrm(ks[10], (DEPTH, N_HEADS, 2 * MAX_KH - 1, 2 * KW - 1)),
        "gn_conv_g": 1.0 + 0.01 * nrm(ks[11], (DEPTH, CONV_CH)),
        "gn_att_g": 1.0 + 0.01 * nrm(ks[12], (DEPTH, ATT_CH)),
        "w_out": nrm(ks[13], (DEPTH, D_MIX, D_MODEL)) * D_MIX ** -0.5,
        "final_g": 1.0 + 0.01 * nrm(ks[14], (D_MODEL,)),
    }


def reference(x, ln_g, w_in, b_in, dw_w, dw_b, cln_g, cln_b, pw_w, pw_b, rpb,
              gn_conv_g, gn_att_g, w_out, final_g):
    h = x
    cuts = [CONV_CH, 2 * CONV_CH, 3 * CONV_CH, 3 * CONV_CH + ATT_CH,
            3 * CONV_CH + 2 * ATT_CH, 3 * CONV_CH + 3 * ATT_CH]
    for l in range(DEPTH):
        hn = rms_norm(h, ln_g[l])
        proj = hn @ w_in[l] + b_in[l]
        glu_a, glu_b, z_conv, q, k, v, z_att = jnp.split(proj, cuts, axis=-1)
        y_conv = conformer_conv(glu_a, glu_b, dw_w[l], dw_b[l], cln_g[l], cln_b[l],
                                pw_w[l], pw_b[l])
        y_att = neighbourhood_attention(q, k, v, rpb[l])
        y_conv = grouped_rms_norm(y_conv, gn_conv_g[l], CONV_GROUPS) * jax.nn.silu(z_conv)
        y_att = grouped_rms_norm(y_att, gn_att_g[l], N_HEADS) * jax.nn.silu(z_att)
        y = jnp.concatenate([y_conv, y_att], axis=-1)
        h = h + y @ w_out[l]
    return rms_norm(h, final_g)
```

```cpp
#include <hip/hip_runtime.h>
#include <hip/hip_cooperative_groups.h>
#include <cstdio>
#include <cstdint>
namespace cg = cooperative_groups;
namespace pg8 {
#define PG8_LAS __attribute__((address_space(3)))
typedef unsigned short bf16_t;
typedef short bf16x8 __attribute__((ext_vector_type(8)));
typedef float f32x4 __attribute__((ext_vector_type(4)));
typedef unsigned u32x4 __attribute__((ext_vector_type(4)));
constexpr int BM = 256, BK = 64, HALF = 128, HTB = HALF * BK * 2  , STAGE_BYTES = 8 * HTB, NXCD = 8, WGM = 8;

__host__ __device__ __forceinline__ int lds_byte(int r, int c) { const int st = (r >> 4) * 2 + (c >> 5), rr = r & 15, cc = c & 31, ob = rr * 64 + cc * 2; return st * 1024 + (ob ^ (((ob >> 9) & 1) << 5)); }
__host__ __device__ __forceinline__ void stage_rc(int b, int& R, int& C) { const int st = b / 1024, sb = b % 1024, swz = sb ^ (((sb >> 9) & 1) << 5); R = (st >> 1) * 16 + swz / 64; C = (st & 1) * 32 + (swz % 64) / 2; }
__host__ __device__ __forceinline__ int perm32(int rho) { const int n = rho >> 4, i = rho & 15; return 8 * (i >> 2) + 4 * n + (i & 3); }

struct Unit { int pm, pn; };
struct Gemm { const bf16_t* A; const bf16_t* Bt; int M, N, K; };

struct StaticOrder {
    int nM, nN, nwg, G, c;
    __host__ __device__ void init(int M, int N, int G_, int c_) { nM = M / BM; nN = N / BM; nwg = nM * nN; G = G_; c = c_; }
    __host__ __device__ bool next(int i, Unit& u) const {
        const long L = (long)i * G + c; if (L >= nwg) return false;
        int wgid = (int)L; { const int q = nwg / NXCD, r = nwg % NXCD, xcd = wgid % NXCD, off = wgid / NXCD; wgid = (xcd < r ? xcd * (q + 1) : r * (q + 1) + (xcd - r) * q) + off; }
        const int nig = WGM * nN, gid = wgid / nig, fm = gid * WGM, gsz = (nM - fm) < WGM ? (nM - fm) : WGM;
        u.pm = fm + ((wgid % nig) % gsz); u.pn = (wgid % nig) / gsz; return true;
    }
    __device__ __forceinline__ void a_ready(const Unit&) const {}
    __device__ __forceinline__ void done(const Unit&) const {}
};

__device__ __forceinline__ unsigned cvt_pk_bf16(float lo, float hi) { unsigned r; asm volatile("v_cvt_pk_bf16_f32 %0, %1, %2" : "=v"(r) : "v"(lo), "v"(hi)); return r; }

__device__ __forceinline__ float sigmoidf_(float v) { return __builtin_amdgcn_rcpf(1.0f + __expf(-v)); }
struct EpiIn {
    static constexpr bool PERM = true, AFTER_DRAIN = false;
    bf16_t* P; const float* bias; const float* rstd; size_t bufstride;
    __device__ __forceinline__ void operator()(const f32x4 (&acc)[2][2][4][2], const Unit& u, int wr, int wc, int fr, int fq) const {
        const int row0 = u.pm * BM + wr * 64 + fr;
        const int cb = u.pn * BM + wc * 32 + 8 * fq;
        f32x4 bv[2][2];
#pragma unroll
        for (int bj = 0; bj < 2; ++bj)
#pragma unroll
            for (int n = 0; n < 2; ++n) bv[bj][n] = *(const f32x4*)(bias + cb + bj * HALF + 4 * n);
        if (u.pn < 4) {
            bf16_t* base = P + (128 * u.pn + wc * 32 + 8 * fq);
#pragma unroll
            for (int ai = 0; ai < 2; ++ai)
#pragma unroll
                for (int m = 0; m < 4; ++m) {
                    const int row = row0 + ai * HALF + m * 16; const float rs = rstd[row];
                    f32x4 a0 = acc[ai][0][m][0] * rs + bv[0][0], a1 = acc[ai][0][m][1] * rs + bv[0][1];
                    f32x4 b0 = acc[ai][1][m][0] * rs + bv[1][0], b1 = acc[ai][1][m][1] * rs + bv[1][1];
#pragma unroll
                    for (int j = 0; j < 4; ++j) { a0[j] *= sigmoidf_(b0[j]); a1[j] *= sigmoidf_(b1[j]); }
                    u32x4 w; w.x = cvt_pk_bf16(a0[0], a0[1]); w.y = cvt_pk_bf16(a0[2], a0[3]); w.z = cvt_pk_bf16(a1[0], a1[1]); w.w = cvt_pk_bf16(a1[2], a1[3]);
                    *(u32x4*)(base + (size_t)row * 512) = w;
                }
        } else {
            const int t = (u.pn - 4) >> 1;
            bf16_t* base = P + (size_t)(t + 1) * bufstride + ((u.pn - 4) & 1) * 256 + wc * 32 + 8 * fq;
            const bool gate = (t == 0) || (t == 4); const float sc = (t == 1) ? 0.125f : 1.0f;
#pragma unroll
            for (int ai = 0; ai < 2; ++ai)
#pragma unroll
                for (int m = 0; m < 4; ++m) {
                    const int row = row0 + ai * HALF + m * 16; const float rs = rstd[row];
#pragma unroll
                    for (int bj = 0; bj < 2; ++bj) {
                        f32x4 v0 = acc[ai][bj][m][0] * rs + bv[bj][0], v1 = acc[ai][bj][m][1] * rs + bv[bj][1];
                        if (gate) {
#pragma unroll
                            for (int j = 0; j < 4; ++j) { v0[j] *= sigmoidf_(v0[j]); v1[j] *= sigmoidf_(v1[j]); }
                        }
                        v0 = v0 * sc; v1 = v1 * sc;
                        u32x4 w; w.x = cvt_pk_bf16(v0[0], v0[1]); w.y = cvt_pk_bf16(v0[2], v0[3]); w.z = cvt_pk_bf16(v1[0], v1[1]); w.w = cvt_pk_bf16(v1[2], v1[3]);
                        *(u32x4*)(base + (size_t)row * 512 + bj * HALF) = w;
                    }
                }
        }
    }
};
struct EpiOut {
    static constexpr bool PERM = true, AFTER_DRAIN = false;
    const float* x; float* out; float* sspart;
    __device__ __forceinline__ void operator()(const f32x4 (&acc)[2][2][4][2], const Unit& u, int wr, int wc, int fr, int fq) const {
        const int row0 = u.pm * BM + wr * 64 + fr;
        const int col0 = u.pn * BM + wc * 32 + 8 * fq;
#pragma unroll
        for (int ai = 0; ai < 2; ++ai)
#pragma unroll
            for (int m = 0; m < 4; ++m) {
                const int row = row0 + ai * HALF + m * 16; float ss = 0.f;
#pragma unroll
                for (int bj = 0; bj < 2; ++bj) {
                    const size_t off = (size_t)row * 1024 + col0 + bj * HALF;
                    const f32x4 x0 = *(const f32x4*)(x + off), x1 = *(const f32x4*)(x + off + 4);
                    const f32x4 h0 = x0 + acc[ai][bj][m][0], h1 = x1 + acc[ai][bj][m][1];
                    *(f32x4*)(out + off) = h0; *(f32x4*)(out + off + 4) = h1;
                    ss += (h0[0] * h0[0] + h0[1] * h0[1]) + (h0[2] * h0[2] + h0[3] * h0[3]) + (h1[0] * h1[0] + h1[1] * h1[1]) + (h1[2] * h1[2] + h1[3] * h1[3]);
                }
                ss += __shfl_xor(ss, 16); ss += __shfl_xor(ss, 32);
                if (fq == 0) sspart[(size_t)row * 16 + u.pn * 4 + wc] = ss;
            }
    }
};

template <class Epi, class Sched, bool ALIGN_EPI = false, bool SP2 = false>
__device__ __forceinline__ void gemm_phase(PG8_LAS unsigned char* lds, const Gemm g, const Sched& S, const Epi& E) {
    const int tid = threadIdx.x, wid = __builtin_amdgcn_readfirstlane(tid >> 6), lane = tid & 63, wr = wid >> 2, wc = wid & 3, fr = lane & 15, fq = lane >> 4;
    const int K = g.K, nt = K / BK;
    unsigned voffA[2], voffB[2];
#pragma unroll
    for (int i = 0; i < 2; ++i) { int R, C; stage_rc(tid * 16 + i * 8192, R, C); const int Rb = Epi::PERM ? ((R & ~31) + perm32(R & 31)) : R;
        voffA[i] = (unsigned)(R * K + C) * 2u; voffB[i] = (unsigned)(Rb * K + C) * 2u; }
    const size_t kstep = (size_t)(BK * 2);
    const size_t hstep = (size_t)HALF * K * 2;
    const size_t tstep = 2 * hstep;
    const unsigned ldsw = (unsigned)wid * 1024u;
    const int aoff = lds_byte(wr * 64 + fr, fq * 8), boff = lds_byte(wc * 32 + fr, fq * 8);
#define PG8_SA(b, h) (((b) * 2 + (h)) * HTB)
#define PG8_SB(b, h) ((4 + (b) * 2 + (h)) * HTB)
#define PG8_STAGE(bufoff, gbase, voff) do { _Pragma("unroll") for (int _i = 0; _i < 2; ++_i) \
        __builtin_amdgcn_global_load_lds((const unsigned*)((const char*)(gbase) + (voff)[_i]), (PG8_LAS unsigned*)(lds + (bufoff) + ldsw + _i * 8192), 16, 0, 0); } while (0)
#define PG8_LDA(dst, b, h) do { _Pragma("unroll") for (int m = 0; m < 4; ++m) _Pragma("unroll") for (int k = 0; k < 2; ++k) dst[m][k] = *(const PG8_LAS bf16x8*)(lds + PG8_SA(b, h) + aoff + m * 2048 + k * 1024); } while (0)
#define PG8_LDB(dst, b, h) do { _Pragma("unroll") for (int n = 0; n < 2; ++n) _Pragma("unroll") for (int k = 0; k < 2; ++k) dst[n][k] = *(const PG8_LAS bf16x8*)(lds + PG8_SB(b, h) + boff + n * 2048 + k * 1024); } while (0)
#define PG8_MMA(ai, bj, At, Bt) do { __builtin_amdgcn_s_setprio(1); _Pragma("unroll") for (int m = 0; m < 4; ++m) _Pragma("unroll") for (int n = 0; n < 2; ++n) _Pragma("unroll") for (int k = 0; k < 2; ++k) \
        acc[ai][bj][m][n] = __builtin_amdgcn_mfma_f32_16x16x32_bf16(Bt[n][k], At[m][k], acc[ai][bj][m][n], 0, 0, 0); __builtin_amdgcn_s_setprio(0); } while (0)
#define PG8_WAIT_V(n) asm volatile("s_waitcnt vmcnt(" #n ")" ::: "memory")
#define PG8_WAIT_L(n) asm volatile("s_waitcnt lgkmcnt(" #n ")" ::: "memory")
#define PG8_BAR __builtin_amdgcn_s_barrier()
#define PG8_SCHED __builtin_amdgcn_sched_barrier(0)
    Unit cur, nxt; int ui = 0;
    if (!S.next(0, cur)) return;
    f32x4 acc[2][2][4][2];
#pragma unroll
    for (int a = 0; a < 2; ++a)
#pragma unroll
        for (int b = 0; b < 2; ++b)
#pragma unroll
            for (int m = 0; m < 4; ++m)
#pragma unroll
                for (int n = 0; n < 2; ++n) acc[a][b][m][n] = (f32x4){0.f, 0.f, 0.f, 0.f};
    bf16x8 At[4][2], B0[2][2], B1[2][2];
    const char* cA = (const char*)g.A + (size_t)cur.pm * tstep; const char* cB = (const char*)g.Bt + (size_t)cur.pn * tstep;
    S.a_ready(cur);
    if constexpr (SP2) {
        PG8_STAGE(PG8_SB(0, 0), cB, voffB); PG8_STAGE(PG8_SB(0, 1), cB + hstep, voffB); PG8_STAGE(PG8_SA(0, 0), cA, voffA); PG8_STAGE(PG8_SA(0, 1), cA + hstep, voffA);
        if (wr == 1) PG8_BAR;
        PG8_WAIT_V(2); PG8_BAR;
        PG8_STAGE(PG8_SB(1, 0), cB + kstep, voffB); PG8_STAGE(PG8_SA(1, 0), cA + kstep, voffA); PG8_STAGE(PG8_SB(1, 1), cB + hstep + kstep, voffB);
        PG8_WAIT_V(6); PG8_BAR;
    } else {
        PG8_STAGE(PG8_SB(0, 0), cB, voffB); PG8_STAGE(PG8_SA(0, 0), cA, voffA); PG8_STAGE(PG8_SB(0, 1), cB + hstep, voffB); PG8_STAGE(PG8_SA(0, 1), cA + hstep, voffA);
        if (wr == 1) PG8_BAR;
        PG8_WAIT_V(4); PG8_BAR;
        PG8_STAGE(PG8_SB(1, 0), cB + kstep, voffB); PG8_STAGE(PG8_SA(1, 0), cA + kstep, voffA); PG8_STAGE(PG8_SB(1, 1), cB + hstep + kstep, voffB);
        PG8_WAIT_V(6); PG8_BAR;
    }
    for (;;) {
        const bool has_next = S.next(ui + 1, nxt);
        const char* nA = has_next ? (const char*)g.A + (size_t)nxt.pm * tstep : cA; const char* nB = has_next ? (const char*)g.Bt + (size_t)nxt.pn * tstep : cB;
        for (int t = 0; t < nt; t += 2) {
            const bool last = (t == nt - 2);
            const char* a1 = cA + (size_t)(t + 1) * kstep;
            const char* a2 = last ? nA : cA + (size_t)(t + 2) * kstep; const char* b2 = last ? nB : cB + (size_t)(t + 2) * kstep;
            const char* a3 = a2 + kstep; const char* b3 = b2 + kstep;
            if (last && has_next) S.a_ready(nxt);
            if constexpr (SP2) {
            PG8_LDB(B0, 0, 0); PG8_LDB(B1, 0, 1); PG8_SCHED; PG8_LDA(At, 0, 0); PG8_STAGE(PG8_SA(1, 1), a1 + hstep, voffA);
            PG8_WAIT_V(8); PG8_WAIT_L(0); PG8_BAR; PG8_MMA(0, 0, At, B0); PG8_MMA(0, 1, At, B1); PG8_BAR; PG8_SCHED;
            PG8_LDA(At, 0, 1); PG8_STAGE(PG8_SB(0, 0), b2, voffB); PG8_STAGE(PG8_SB(0, 1), b2 + hstep, voffB); PG8_STAGE(PG8_SA(0, 0), a2, voffA);
            PG8_WAIT_V(8); PG8_WAIT_L(0); PG8_BAR; PG8_MMA(1, 0, At, B0); PG8_MMA(1, 1, At, B1); PG8_BAR; PG8_SCHED;
            PG8_LDB(B0, 1, 0); PG8_LDB(B1, 1, 1); PG8_SCHED; PG8_LDA(At, 1, 0); PG8_STAGE(PG8_SA(0, 1), a2 + hstep, voffA);
            PG8_WAIT_V(8); PG8_WAIT_L(0); PG8_BAR; PG8_MMA(0, 0, At, B0); PG8_MMA(0, 1, At, B1); PG8_BAR; PG8_SCHED;
            PG8_LDA(At, 1, 1); PG8_STAGE(PG8_SB(1, 0), b3, voffB); PG8_STAGE(PG8_SB(1, 1), b3 + hstep, voffB); PG8_STAGE(PG8_SA(1, 0), a3, voffA);
            PG8_WAIT_V(8); PG8_WAIT_L(0); PG8_BAR; PG8_MMA(1, 0, At, B0); PG8_MMA(1, 1, At, B1); PG8_BAR; PG8_SCHED;
            } else {
            PG8_LDB(B0, 0, 0); PG8_SCHED; PG8_LDA(At, 0, 0); PG8_STAGE(PG8_SA(1, 1), a1 + hstep, voffA);
            PG8_WAIT_L(8); PG8_BAR; PG8_WAIT_L(0); PG8_MMA(0, 0, At, B0); PG8_BAR; PG8_SCHED;
            PG8_LDB(B1, 0, 1); PG8_STAGE(PG8_SB(0, 0), b2, voffB);
            PG8_BAR; PG8_WAIT_L(0); PG8_MMA(0, 1, At, B1); PG8_BAR;
            PG8_LDA(At, 0, 1); PG8_STAGE(PG8_SA(0, 0), a2, voffA);
            PG8_BAR; PG8_WAIT_L(0); PG8_MMA(1, 0, At, B0); PG8_BAR; PG8_SCHED;
            PG8_STAGE(PG8_SB(0, 1), b2 + hstep, voffB);
            PG8_WAIT_V(6); PG8_BAR; PG8_MMA(1, 1, At, B1); PG8_BAR;
            PG8_LDB(B0, 1, 0); PG8_SCHED; PG8_LDA(At, 1, 0); PG8_STAGE(PG8_SA(0, 1), a2 + hstep, voffA);
            PG8_WAIT_L(8); PG8_BAR; PG8_WAIT_L(0); PG8_MMA(0, 0, At, B0); PG8_BAR; PG8_SCHED;
            PG8_LDB(B1, 1, 1); PG8_STAGE(PG8_SB(1, 0), b3, voffB);
            PG8_BAR; PG8_WAIT_L(0); PG8_MMA(0, 1, At, B1); PG8_BAR;
            PG8_LDA(At, 1, 1); PG8_STAGE(PG8_SA(1, 0), a3, voffA);
            PG8_BAR; PG8_WAIT_L(0); PG8_MMA(1, 0, At, B0); PG8_BAR; PG8_SCHED;
            PG8_STAGE(PG8_SB(1, 1), b3 + hstep, voffB);
            PG8_WAIT_V(6); PG8_BAR; PG8_MMA(1, 1, At, B1); PG8_BAR;
            }
        }
        if constexpr (ALIGN_EPI) { if (wr == 0) PG8_BAR; }
        if constexpr (!Epi::AFTER_DRAIN) { E(acc, cur, wr, wc, fr, fq); S.done(cur); }
        if (!has_next) break;
#pragma unroll
        for (int a = 0; a < 2; ++a)
#pragma unroll
            for (int b = 0; b < 2; ++b)
#pragma unroll
                for (int m = 0; m < 4; ++m)
#pragma unroll
                    for (int n = 0; n < 2; ++n) acc[a][b][m][n] = (f32x4){0.f, 0.f, 0.f, 0.f};
        cur = nxt; cA = nA; cB = nB; ++ui;
        if constexpr (ALIGN_EPI) { if (wr == 1) PG8_BAR; }
    }
    PG8_WAIT_V(0);
    if constexpr (!ALIGN_EPI) { if (wr == 0) PG8_BAR; }
    PG8_BAR;
    if constexpr (Epi::AFTER_DRAIN) { E.fused(acc, cur, wr, wc, fr, fq, lds, wid, lane); S.done(cur); }
#undef PG8_SA
#undef PG8_SB
#undef PG8_STAGE
#undef PG8_LDA
#undef PG8_LDB
#undef PG8_MMA
#undef PG8_WAIT_V
#undef PG8_WAIT_L
#undef PG8_BAR
#undef PG8_SCHED
}
}

#ifndef MK_LAUNCHES
#define MK_LAUNCHES 1
#endif
typedef unsigned short bf16;
typedef short bf16x8 __attribute__((ext_vector_type(8)));
typedef short s16x4 __attribute__((ext_vector_type(4)));
typedef float f32x4 __attribute__((ext_vector_type(4)));
typedef float f32x16 __attribute__((ext_vector_type(16)));
typedef unsigned u32x4 __attribute__((ext_vector_type(4)));
typedef unsigned u32x2 __attribute__((ext_vector_type(2)));
#define LASX __attribute__((address_space(3)))

constexpr int BATCH = 2, SEQ = 8192, D = 1024, M = BATCH * SEQ, NPROJ = 3584;
constexpr float EPS = 1e-6f;
constexpr size_t MiB = 1u << 20;
constexpr size_t WS_WIN = 1 * MiB, WS_WOUT = 9 * MiB, WS_PW = 11 * MiB, WS_BIAS = 12 * MiB, WS_RSTD = 12 * MiB + 65536, WS_SSP = 13 * MiB;
constexpr size_t WS_XB = 16 * MiB, WS_P = 48 * MiB, WS_Y = 144 * MiB, WS_END = 176 * MiB;
constexpr size_t PBUF = (size_t)M * 512;
constexpr int LDS_BYTES = 147456;
constexpr int NTHREADS = 512, NWAVES = 8;

__device__ __forceinline__ float bf_lo(unsigned u) { return __builtin_bit_cast(float, u << 16); }
__device__ __forceinline__ float bf_hi(unsigned u) { return __builtin_bit_cast(float, u & 0xffff0000u); }
__device__ __forceinline__ unsigned pkbf(float lo, float hi) { unsigned r; asm("v_cvt_pk_bf16_f32 %0, %1, %2" : "=v"(r) : "v"(lo), "v"(hi)); return r; }
__device__ __forceinline__ float wave_sum(float v) {
#pragma unroll
    for (int o = 1; o < 64; o <<= 1) v += __shfl_xor(v, o);
    return v;
}
#define LDS_WAIT() asm volatile("s_waitcnt lgkmcnt(0)" ::: "memory")

__device__ __forceinline__ int colmap(int n) {
    if (n >= 1024) return n;
    if (n < 512) return 256 * (n >> 7) + (n & 127);
    n -= 512; return 256 * (n >> 7) + 128 + (n & 127);
}
__device__ __forceinline__ void transpose_item(const float* __restrict__ W, const float* __restrict__ g, int K, int N, bf16* WT, bool remap, float* scr, int item, int lane) {
    const int nblk = N / 32, kb = item / nblk, nb = item % nblk, k0 = 64 * kb, n0 = 32 * nb;
#pragma unroll 8
    for (int i = 0; i < 32; ++i) { const int kk = 2 * i + (lane >> 5); float v = W[(size_t)(k0 + kk) * N + n0 + (lane & 31)]; if (g) v *= g[k0 + kk]; scr[kk * 33 + (lane & 31)] = v; }
    LDS_WAIT();
    const int c = lane & 7; const int row_off = remap ? colmap(n0) : n0;
#pragma unroll
    for (int j = 0; j < 4; ++j) { const int n = (lane >> 3) + 8 * j; const float* s = scr + (8 * c) * 33 + n;
        u32x4 o; o.x = pkbf(s[0 * 33], s[1 * 33]); o.y = pkbf(s[2 * 33], s[3 * 33]); o.z = pkbf(s[4 * 33], s[5 * 33]); o.w = pkbf(s[6 * 33], s[7 * 33]);
        *(u32x4*)(WT + (size_t)(row_off + n) * K + k0 + 8 * c) = o; }
    LDS_WAIT();
}

struct Args { const float* in[15]; float* out; unsigned char* ws; int ph_lo, ph_hi; int pad0, pad1; };

__device__ __forceinline__ void p0_prologue(unsigned char* lds, const Args& a, int G) {
    const int tid = threadIdx.x, lane = tid & 63, wave = tid >> 6;
    const float* x = a.in[0]; const float* ln_g = a.in[1]; const float* w_in = a.in[2]; const float* b_in = a.in[3];
    const float* pw_w = a.in[8]; const float* w_out = a.in[13];
    bf16* Wt_in = (bf16*)(a.ws + WS_WIN); bf16* Wt_out = (bf16*)(a.ws + WS_WOUT); bf16* Wt_pw = (bf16*)(a.ws + WS_PW);
    float* biasp = (float*)(a.ws + WS_BIAS); float* rstd = (float*)(a.ws + WS_RSTD); bf16* XB = (bf16*)(a.ws + WS_XB);
    float* scr = (float*)(lds + wave * 16384);
    const int gw = blockIdx.x * NWAVES + wave, NGW = G * NWAVES;
    constexpr int I_IN = (D / 64) * (NPROJ / 32), I_OUT = (D / 64) * (D / 32), I_PW = (512 / 64) * (512 / 32);
    for (int it = gw; it < I_IN + I_OUT + I_PW; it += NGW) {
        int r = it;
        if (r < I_IN) { transpose_item(w_in, ln_g, D, NPROJ, Wt_in, true, scr, r, lane); continue; } r -= I_IN;
        if (r < I_OUT) { transpose_item(w_out, nullptr, D, D, Wt_out, false, scr, r, lane); continue; } r -= I_OUT;
        transpose_item(pw_w, nullptr, 512, 512, Wt_pw, false, scr, r, lane);
    }
    for (int n = blockIdx.x * NTHREADS + tid; n < NPROJ; n += G * NTHREADS) biasp[colmap(n)] = b_in[n];
    for (int m = gw; m < M; m += NGW) {
        const f32x4* xr = (const f32x4*)(x + (size_t)m * D) + lane;
        f32x4 v[4]; float s = 0.f;
#pragma unroll
        for (int j = 0; j < 4; ++j) { v[j] = xr[64 * j]; s += (v[j].x * v[j].x + v[j].y * v[j].y) + (v[j].z * v[j].z + v[j].w * v[j].w); }
        s = wave_sum(s);
        if (lane == 0) rstd[m] = 1.0f / sqrtf(s * (1.0f / D) + EPS);
        u32x2* o8 = (u32x2*)(XB + (size_t)m * D) + lane;
#pragma unroll
        for (int j = 0; j < 4; ++j) { u32x2 o; o.x = pkbf(v[j].x, v[j].y); o.y = pkbf(v[j].z, v[j].w); o8[64 * j] = o; }
    }
}

constexpr int CV_W_PITCH = 144, CV_W_BYTES = 512 * CV_W_PITCH;
constexpr int CV_VN_OFF = CV_W_BYTES, CV_VN_PITCH = 1040;
static_assert(CV_VN_OFF + 32 * CV_VN_PITCH <= LDS_BYTES && 62 * 1024 <= CV_W_BYTES, "conv LDS map");

__device__ __forceinline__ void conv_unit(unsigned char* lds, int unit, const bf16* __restrict__ U, const bf16* __restrict__ ZC, const float* __restrict__ dw_w, const float* __restrict__ dw_b,
                                          const float* __restrict__ cln_g, const float* __restrict__ cln_b, const bf16* __restrict__ pw_t, const float* __restrict__ pw_b,
                                          const float* __restrict__ gn_g, bf16* __restrict__ Y) {
    const int tid = threadIdx.x, lane = tid & 63, w = tid >> 6;
    const int b = unit >> 8, tok0 = (unit & 255) * 32;
    const size_t rowbase = (size_t)b * SEQ;
    for (int idx = tid; idx < 62 * 64; idx += NTHREADS) {
        const int row = idx >> 6, ch = idx & 63, t = tok0 - 15 + row;
        u32x4 v = {0u, 0u, 0u, 0u};
        if (t >= 0 && t < SEQ) v = *(const u32x4*)(U + (rowbase + t) * 512 + ch * 8);
        *(u32x4*)(lds + row * 1024 + ch * 16) = v;
    }
    const int cp = tid & 255, th = tid >> 8;
    float w0[31], w1[31];
#pragma unroll
    for (int j = 0; j < 31; ++j) { const float2 ww = *(const float2*)(dw_w + j * 512 + 2 * cp); w0[j] = ww.x; w1[j] = ww.y; }
    float a0[16], a1[16];
    { const float2 bb = *(const float2*)(dw_b + 2 * cp);
#pragma unroll
      for (int o = 0; o < 16; ++o) { a0[o] = bb.x; a1[o] = bb.y; } }
    __syncthreads();
#pragma unroll
    for (int i = 0; i < 46; ++i) {
        const unsigned uu = *(const unsigned*)(lds + (16 * th + i) * 1024 + cp * 4);
        const float u0 = bf_lo(uu), u1 = bf_hi(uu);
#pragma unroll
        for (int j = 0; j < 31; ++j) { const int o = i - j; if (o >= 0 && o < 16) { a0[o] = fmaf(w0[j], u0, a0[o]); a1[o] = fmaf(w1[j], u1, a1[o]); } }
        if ((i & 7) == 7) __builtin_amdgcn_sched_barrier(0);
    }
#pragma unroll
    for (int o = 0; o < 16; ++o) *(unsigned*)(lds + CV_VN_OFF + (16 * th + o) * CV_VN_PITCH + cp * 4) = pkbf(a0[o], a1[o]);
    __syncthreads();
    u32x4 wreg[8];
    const int wrow = tid >> 3, wch = tid & 7;
#define CV_LOADW(kc) do { unsigned wo_ = (unsigned)(wrow * 1024 + wch * 16 + (kc) * 128); asm volatile("" : "+v"(wo_)); \
        _Pragma("unroll") for (int i = 0; i < 8; ++i) wreg[i] = *(const u32x4*)((const unsigned char*)pw_t + (wo_ + (unsigned)i * 65536u)); } while (0)
#define CV_STOREW() do { _Pragma("unroll") for (int i = 0; i < 8; ++i) *(u32x4*)(lds + (wrow + 64 * i) * CV_W_PITCH + wch * 16) = wreg[i]; } while (0)
    CV_LOADW(0);
    {
        const f32x4 g0 = *(const f32x4*)(cln_g + 8 * lane), g1 = *(const f32x4*)(cln_g + 8 * lane + 4);
        const f32x4 c0 = *(const f32x4*)(cln_b + 8 * lane), c1 = *(const f32x4*)(cln_b + 8 * lane + 4);
#pragma unroll
        for (int tt = 0; tt < 4; ++tt) {
            unsigned char* p = lds + CV_VN_OFF + (4 * w + tt) * CV_VN_PITCH + lane * 16;
            const u32x4 raw = *(const u32x4*)p;
            float v[8] = {bf_lo(raw.x), bf_hi(raw.x), bf_lo(raw.y), bf_hi(raw.y), bf_lo(raw.z), bf_hi(raw.z), bf_lo(raw.w), bf_hi(raw.w)};
            float s = 0.f;
#pragma unroll
            for (int e = 0; e < 8; ++e) s += v[e];
            const float mean = wave_sum(s) * (1.0f / 512.0f);
            float q = 0.f;
#pragma unroll
            for (int e = 0; e < 8; ++e) { v[e] -= mean; q += v[e] * v[e]; }
            const float rstd = 1.0f / sqrtf(wave_sum(q) * (1.0f / 512.0f) + EPS);
            const float gg[8] = {g0[0], g0[1], g0[2], g0[3], g1[0], g1[1], g1[2], g1[3]};
            const float cc[8] = {c0[0], c0[1], c0[2], c0[3], c1[0], c1[1], c1[2], c1[3]};
#pragma unroll
            for (int e = 0; e < 8; ++e) { const float n = v[e] * rstd * gg[e] + cc[e]; v[e] = n * pg8::sigmoidf_(n); }
            u32x4 o; o.x = pkbf(v[0], v[1]); o.y = pkbf(v[2], v[3]); o.z = pkbf(v[4], v[5]); o.w = pkbf(v[6], v[7]);
            *(u32x4*)p = o;
        }
    }
    CV_STOREW();
    __syncthreads();
    const int r32 = lane & 31, h2 = lane >> 5;
    f32x16 acc[2];
#pragma unroll
    for (int a = 0; a < 2; ++a)
#pragma unroll
        for (int e = 0; e < 16; ++e) acc[a][e] = 0.f;
    for (int kc = 0; kc < 8; ++kc) {
        if (kc < 7) CV_LOADW(kc + 1);
#pragma unroll
        for (int s = 0; s < 4; ++s) {
            const bf16x8 bfr = *(const bf16x8*)(lds + CV_VN_OFF + r32 * CV_VN_PITCH + (kc * 64 + s * 16 + 8 * h2) * 2);
#pragma unroll
            for (int a = 0; a < 2; ++a) {
                const bf16x8 afr = *(const bf16x8*)(lds + (64 * w + 32 * a + r32) * CV_W_PITCH + (s * 16 + 8 * h2) * 2);
                acc[a] = __builtin_amdgcn_mfma_f32_32x32x16_bf16(afr, bfr, acc[a], 0, 0, 0);
            }
        }
        __syncthreads();
        if (kc < 7) { CV_STOREW(); __syncthreads(); }
    }
#undef CV_LOADW
#undef CV_STOREW
    const size_t row = rowbase + tok0 + r32;
    float ss = 0.f;
#pragma unroll
    for (int a = 0; a < 2; ++a)
#pragma unroll
        for (int rg = 0; rg < 4; ++rg) {
            const f32x4 pb = *(const f32x4*)(pw_b + 64 * w + 32 * a + 8 * rg + 4 * h2);
#pragma unroll
            for (int j = 0; j < 4; ++j) { const float v = acc[a][4 * rg + j] + pb[j]; acc[a][4 * rg + j] = v; ss += v * v; }
        }
    ss += __shfl_xor(ss, 32);
    const float rstd = 1.0f / sqrtf(ss * (1.0f / 64.0f) + EPS);
#pragma unroll
    for (int a = 0; a < 2; ++a)
#pragma unroll
        for (int rg = 0; rg < 4; ++rg) {
            const int oc0 = 64 * w + 32 * a + 8 * rg + 4 * h2;
            const f32x4 g = *(const f32x4*)(gn_g + oc0);
            const u32x2 z = *(const u32x2*)(ZC + row * 512 + oc0);
            u32x2 o;
            o.x = pkbf(acc[a][4 * rg + 0] * rstd * g[0] * bf_lo(z.x), acc[a][4 * rg + 1] * rstd * g[1] * bf_hi(z.x));
            o.y = pkbf(acc[a][4 * rg + 2] * rstd * g[2] * bf_lo(z.y), acc[a][4 * rg + 3] * rstd * g[3] * bf_hi(z.y));
            *(u32x2*)(Y + row * 1024 + oc0) = o;
        }
}

constexpr int AT_RPB_OFF = 2 * 8 * 64 * 128;
static_assert(AT_RPB_OFF + 2 * 465 * 4 <= LDS_BYTES, "attention LDS map");
__device__ __forceinline__ s16x4 vtr(const unsigned char* p) {
    typedef short v4i16_t __attribute__((ext_vector_type(4)));
    return __builtin_bit_cast(s16x4, __builtin_amdgcn_ds_read_tr16_b64_v4i16((LASX v4i16_t*)p));
}
__device__ __forceinline__ void attn_unit(unsigned char* lds, int unit, const bf16* __restrict__ Q, const bf16* __restrict__ K, const bf16* __restrict__ V, const bf16* __restrict__ ZA,
                                          const float* __restrict__ rpb, const float* __restrict__ gn_g, bf16* __restrict__ Y) {
    const int tid = threadIdx.x, lane = tid & 63, w = tid >> 6;
    const int b = unit >> 9, hp = (unit >> 7) & 3, r = unit & 127;
    const int rs = min(max(r - 4, 0), 120);
    const size_t rowbase = (size_t)b * SEQ;
    for (int idx = tid; idx < 8192; idx += NTHREADS) {
        const int tr = idx >> 4, c16 = idx & 15, i = tr >> 6, tok = tr & 63, head = c16 >> 3, ch = c16 & 7;
        const u32x4 v = *(const u32x4*)(V + (rowbase + (size_t)(rs + i) * 64 + tok) * 512 + hp * 128 + c16 * 8);
        *(u32x4*)(lds + head * 65536 + tr * 128 + (((ch >> 1) ^ ((tok >> 1) & 3)) << 5) + ((ch & 1) << 4)) = v;
    }
    for (int idx = tid; idx < 930; idx += NTHREADS) ((float*)(lds + AT_RPB_OFF))[idx] = rpb[hp * 930 + idx];
    __syncthreads();
    const int hl = w >> 2, c = w & 3, h = 2 * hp + hl;
    const int wc0 = (c == 0) ? 0 : (c == 1) ? 8 : (c == 2) ? 24 : 32;
    const int l16 = lane & 15, g = lane >> 4;
    const size_t tq = rowbase + (size_t)r * 64 + 16 * c + l16;
    const bf16x8 qf0 = *(const bf16x8*)(Q + tq * 512 + h * 64 + 8 * g), qf1 = *(const bf16x8*)(Q + tq * 512 + h * 64 + 32 + 8 * g);
    f32x4 st[8][2];
#pragma unroll
    for (int i = 0; i < 8; ++i)
#pragma unroll
        for (int hh = 0; hh < 2; ++hh) {
            const bf16* kp = K + (rowbase + (size_t)(rs + i) * 64 + wc0 + 16 * hh + l16) * 512 + h * 64 + 8 * g;
            const bf16x8 k0 = *(const bf16x8*)kp, k1 = *(const bf16x8*)(kp + 32);
            f32x4 z = {0.f, 0.f, 0.f, 0.f};
            z = __builtin_amdgcn_mfma_f32_16x16x32_bf16(k0, qf0, z, 0, 0, 0);
            z = __builtin_amdgcn_mfma_f32_16x16x32_bf16(k1, qf1, z, 0, 0, 0);
            st[i][hh] = z;
        }
    const int wq = 16 * c + l16, cs = min(max(wq - 8, 0), 48);
    const float* tbl = (const float*)(lds + AT_RPB_OFF) + hl * 465;
    float mx = -1e30f;
#pragma unroll
    for (int i = 0; i < 8; ++i) {
        const int rowoff = (rs + i - r + 7) * 31 - wq + 15;
#pragma unroll
        for (int hh = 0; hh < 2; ++hh)
#pragma unroll
            for (int j = 0; j < 4; ++j) {
                const int kc = wc0 + 16 * hh + 4 * g + j;
                const bool inw = (kc >= cs) && (kc < cs + 16);
                const float bias = tbl[inw ? rowoff + kc : 0];
                const float s = inw ? st[i][hh][j] + bias : -1e30f;
                st[i][hh][j] = s; mx = fmaxf(mx, s);
            }
    }
    mx = fmaxf(mx, __shfl_xor(mx, 16)); mx = fmaxf(mx, __shfl_xor(mx, 32));
    float sum = 0.f;
#pragma unroll
    for (int i = 0; i < 8; ++i)
#pragma unroll
        for (int hh = 0; hh < 2; ++hh)
#pragma unroll
            for (int j = 0; j < 4; ++j) { const float p = __builtin_amdgcn_exp2f((st[i][hh][j] - mx) * 1.4426950408889634f); st[i][hh][j] = p; sum += p; }
    sum += __shfl_xor(sum, 16); sum += __shfl_xor(sum, 32);
    const unsigned char* vb = lds + hl * 65536;
    const int qq = l16 >> 2, pp = l16 & 3;
    const int key0 = wc0 + 4 * g + qq, sw = (key0 >> 1) & 3;
    f32x4 o[4];
#pragma unroll
    for (int ht = 0; ht < 4; ++ht) o[ht] = (f32x4){0.f, 0.f, 0.f, 0.f};
#pragma unroll
    for (int i = 0; i < 8; ++i) {
        u32x4 pw; pw.x = pkbf(st[i][0][0], st[i][0][1]); pw.y = pkbf(st[i][0][2], st[i][0][3]); pw.z = pkbf(st[i][1][0], st[i][1][1]); pw.w = pkbf(st[i][1][2], st[i][1][3]);
        const bf16x8 pf = __builtin_bit_cast(bf16x8, pw);
#pragma unroll
        for (int ht = 0; ht < 4; ++ht) {
            const unsigned char* a0 = vb + (i * 64 + key0) * 128 + ((ht ^ sw) << 5) + 8 * pp;
            const s16x4 lo = vtr(a0), hi = vtr(a0 + 16 * 128);
            const bf16x8 vf = __builtin_shufflevector(lo, hi, 0, 1, 2, 3, 4, 5, 6, 7);
            o[ht] = __builtin_amdgcn_mfma_f32_16x16x32_bf16(vf, pf, o[ht], 0, 0, 0);
        }
    }
    const float inv = 1.0f / sum;
    float ss = 0.f;
#pragma unroll
    for (int ht = 0; ht < 4; ++ht)
#pragma unroll
        for (int j = 0; j < 4; ++j) { const float v = o[ht][j] * inv; o[ht][j] = v; ss += v * v; }
    ss += __shfl_xor(ss, 16); ss += __shfl_xor(ss, 32);
    const float rstd = 1.0f / sqrtf(ss * (1.0f / 64.0f) + EPS);
#pragma unroll
    for (int ht = 0; ht < 4; ++ht) {
        const int ch = h * 64 + 16 * ht + 4 * g;
        const f32x4 gg = *(const f32x4*)(gn_g + ch);
        const u32x2 z = *(const u32x2*)(ZA + tq * 512 + ch);
        u32x2 ov;
        ov.x = pkbf(o[ht][0] * rstd * gg[0] * bf_lo(z.x), o[ht][1] * rstd * gg[1] * bf_hi(z.x));
        ov.y = pkbf(o[ht][2] * rstd * gg[2] * bf_lo(z.y), o[ht][3] * rstd * gg[3] * bf_hi(z.y));
        *(u32x2*)(Y + tq * 1024 + 512 + ch) = ov;
    }
    __syncthreads();
}

__global__ void __launch_bounds__(NTHREADS, 2) fwd_mega(Args a) {
    extern __shared__ __attribute__((aligned(16))) unsigned char lds[];
    cg::grid_group grid = cg::this_grid();
    const int G = gridDim.x, tid = threadIdx.x, lane = tid & 63, wave = tid >> 6;
    const int lo = a.ph_lo, hi = a.ph_hi;
    unsigned char* ws = a.ws;
    bf16* P = (bf16*)(ws + WS_P); bf16* Yb = (bf16*)(ws + WS_Y);
#define IN(k) (lo <= (k) && (k) < hi)
#define SEAM(k) do { if (IN(k) && IN((k) + 1)) grid.sync(); } while (0)
#ifndef SKIP_P0
    if (IN(0)) p0_prologue(lds, a, G);
#endif
    SEAM(0);
#ifndef SKIP_P1
    if (IN(1)) {
        pg8::Gemm g{(const pg8::bf16_t*)(ws + WS_XB), (const pg8::bf16_t*)(ws + WS_WIN), M, NPROJ, D};
        pg8::StaticOrder S; S.init(M, NPROJ, G, (int)blockIdx.x);
        pg8::EpiIn E{(pg8::bf16_t*)P, (const float*)(ws + WS_BIAS), (const float*)(ws + WS_RSTD), PBUF};
        pg8::gemm_phase<pg8::EpiIn, pg8::StaticOrder, true, true>((PG8_LAS unsigned char*)lds, g, S, E);
    }
#endif
    SEAM(1);
    if (IN(2)) {
        const int vcu = (G % 8 == 0) ? (int)(blockIdx.x % 8) * (G / 8) + (int)blockIdx.x / 8 : (int)blockIdx.x;
        for (int u = vcu; u < 512 + 1024; u += G) {
#ifndef SKIP_CONV
            if (u < 512) conv_unit(lds, u, P, P + PBUF, a.in[4], a.in[5], a.in[6], a.in[7], (const bf16*)(ws + WS_PW), a.in[9], a.in[11], Yb);
#endif
#ifndef SKIP_ATTN
            if (u >= 512) attn_unit(lds, u - 512, P + 2 * PBUF, P + 3 * PBUF, P + 4 * PBUF, P + 5 * PBUF, a.in[10], a.in[12], Yb);
#endif
        }
    }
    SEAM(2);
#ifndef SKIP_P3
    if (IN(3)) {
        pg8::Gemm g{(const pg8::bf16_t*)Yb, (const pg8::bf16_t*)(ws + WS_WOUT), M, D, D};
        pg8::StaticOrder S; S.init(M, D, G, (int)blockIdx.x);
        pg8::EpiOut E{a.in[0], a.out, (float*)(ws + WS_SSP)};
        pg8::gemm_phase<pg8::EpiOut, pg8::StaticOrder, true, true>((PG8_LAS unsigned char*)lds, g, S, E);
    }
#endif
    SEAM(3);
    if (IN(4)) {
        const float* ssp = (const float*)(ws + WS_SSP); const float* fg = a.in[14];
        f32x4 gv[4];
#pragma unroll
        for (int j = 0; j < 4; ++j) gv[j] = *((const f32x4*)fg + lane + 64 * j);
        for (int m = blockIdx.x * NWAVES + wave; m < M; m += G * NWAVES) {
            float s = (lane < 16) ? ssp[(size_t)m * 16 + lane] : 0.f;
            s = wave_sum(s);
            const float rstd = 1.0f / sqrtf(s * (1.0f / D) + EPS);
            f32x4* o = (f32x4*)(a.out + (size_t)m * D) + lane;
#pragma unroll
            for (int j = 0; j < 4; ++j) { f32x4 v = o[64 * j]; v = v * rstd * gv[j]; o[64 * j] = v; }
        }
    }
#undef IN
#undef SEAM
}

extern "C" void kernel_launch(void* const* d_in, const int* in_sizes, int n_in, void* d_out, int out_size, void* d_ws, size_t ws_size, hipStream_t stream) {
    static int grid = 0;
    if (grid == 0) {
        if (n_in != 15 || in_sizes[0] != M * D || out_size != M * D || ws_size < WS_END) { fprintf(stderr, "kernel_launch: unexpected shapes (n_in %d, in0 %d, out %d, ws %zu)\n", n_in, n_in > 0 ? in_sizes[0] : -1, out_size, ws_size); grid = -1; return; }
        int dev = 0, cus = 0, per_cu = 0;
        hipGetDevice(&dev);
        hipDeviceGetAttribute(&cus, hipDeviceAttributeMultiprocessorCount, dev);
        if (hipFuncSetAttribute((const void*)fwd_mega, hipFuncAttributeMaxDynamicSharedMemorySize, LDS_BYTES) != hipSuccess) { fprintf(stderr, "kernel_launch: hipFuncSetAttribute failed\n"); grid = -1; return; }
        if (hipOccupancyMaxActiveBlocksPerMultiprocessor(&per_cu, (const void*)fwd_mega, NTHREADS, LDS_BYTES) != hipSuccess || per_cu < 1) { fprintf(stderr, "kernel_launch: occupancy query says %d blocks per CU\n", per_cu); per_cu = 1; }
        (void)hipGetLastError();
        grid = cus * per_cu;
    }
    if (grid < 0) return;
    Args a{};
    for (int i = 0; i < 15; ++i) a.in[i] = (const float*)d_in[i];
    a.out = (float*)d_out; a.ws = (unsigned char*)d_ws;
#if MK_LAUNCHES == 1
    a.ph_lo = 0; a.ph_hi = 5;
    void* args[] = {&a};
    hipError_t e = hipLaunchCooperativeKernel((const void*)fwd_mega, dim3(grid), dim3(NTHREADS), args, LDS_BYTES, stream);
    if (e != hipSuccess) fprintf(stderr, "kernel_launch: cooperative launch failed: %s (grid %d)\n", hipGetErrorString(e), grid);
#else
    for (int k = 0; k < 5; ++k) {
        a.ph_lo = k; a.ph_hi = k + 1;
        hipLaunchKernelGGL(fwd_mega, dim3(grid), dim3(NTHREADS), LDS_BYTES, stream, a);
    }
#endif
}
```

```cpp
#include <hip/hip_runtime.h>
#include <hip/hip_cooperative_groups.h>
#include <cstdio>
#include <cstdint>
namespace cg = cooperative_groups;
namespace pg8 {
#define PG8_LAS __attribute__((address_space(3)))
typedef unsigned short bf16_t;
typedef short bf16x8 __attribute__((ext_vector_type(8)));
typedef float f32x4 __attribute__((ext_vector_type(4)));
typedef unsigned u32x4 __attribute__((ext_vector_type(4)));
constexpr int BM = 256, BK = 64, HALF = 128, HTB = HALF * BK * 2  , STAGE_BYTES = 8 * HTB, NXCD = 8, WGM = 8;

__host__ __device__ __forceinline__ int lds_byte(int r, int c) { const int st = (r >> 4) * 2 + (c >> 5), rr = r & 15, cc = c & 31, ob = rr * 64 + cc * 2; return st * 1024 + (ob ^ (((ob >> 9) & 1) << 5)); }
__host__ __device__ __forceinline__ void stage_rc(int b, int& R, int& C) { const int st = b / 1024, sb = b % 1024, swz = sb ^ (((sb >> 9) & 1) << 5); R = (st >> 1) * 16 + swz / 64; C = (st & 1) * 32 + (swz % 64) / 2; }
__host__ __device__ __forceinline__ int perm32(int rho) { const int n = rho >> 4, i = rho & 15; return 8 * (i >> 2) + 4 * n + (i & 3); }

struct Unit { int pm, pn; };
struct Gemm { const bf16_t* A; const bf16_t* Bt; int M, N, K; };

struct StaticOrder {
    int nM, nN, nwg, G, c;
    __host__ __device__ void init(int M, int N, int G_, int c_) { nM = M / BM; nN = N / BM; nwg = nM * nN; G = G_; c = c_; }
    __host__ __device__ bool next(int i, Unit& u) const {
        const long L = (long)i * G + c; if (L >= nwg) return false;
        int wgid = (int)L; { const int q = nwg / NXCD, r = nwg % NXCD, xcd = wgid % NXCD, off = wgid / NXCD; wgid = (xcd < r ? xcd * (q + 1) : r * (q + 1) + (xcd - r) * q) + off; }
        const int nig = WGM * nN, gid = wgid / nig, fm = gid * WGM, gsz = (nM - fm) < WGM ? (nM - fm) : WGM;
        u.pm = fm + ((wgid % nig) % gsz); u.pn = (wgid % nig) / gsz; return true;
    }
    __device__ __forceinline__ void a_ready(const Unit&) const {}
    __device__ __forceinline__ void done(const Unit&) const {}
};

template <int REP> struct RepOrder : StaticOrder {
    __host__ __device__ bool next(int i, Unit& u) const {
        if constexpr (REP > 1) { const int per = (nwg - c + G - 1) / G; if (i >= per * REP) return false; i %= per; }
        return StaticOrder::next(i, u);
    }
};
__device__ __forceinline__ unsigned cvt_pk_bf16(float lo, float hi) { unsigned r; asm volatile("v_cvt_pk_bf16_f32 %0, %1, %2" : "=v"(r) : "v"(lo), "v"(hi)); return r; }

__device__ __forceinline__ float sigmoidf_(float v) { return __builtin_amdgcn_rcpf(1.0f + __expf(-v)); }
struct EpiIn {
    static constexpr bool PERM = true, AFTER_DRAIN = false;
    bf16_t* P; const float* bias; const float* rstd; size_t bufstride;
    __device__ __forceinline__ void operator()(const f32x4 (&acc)[2][2][4][2], const Unit& u, int wr, int wc, int fr, int fq) const {
        const int row0 = u.pm * BM + wr * 64 + fr;
        const int cb = u.pn * BM + wc * 32 + 8 * fq;
        f32x4 bv[2][2];
#pragma unroll
        for (int bj = 0; bj < 2; ++bj)
#pragma unroll
            for (int n = 0; n < 2; ++n) bv[bj][n] = *(const f32x4*)(bias + cb + bj * HALF + 4 * n);
        if (u.pn < 4) {
            bf16_t* base = P + (128 * u.pn + wc * 32 + 8 * fq);
#pragma unroll
            for (int ai = 0; ai < 2; ++ai)
#pragma unroll
                for (int m = 0; m < 4; ++m) {
                    const int row = row0 + ai * HALF + m * 16; const float rs = rstd[row];
                    f32x4 a0 = acc[ai][0][m][0] * rs + bv[0][0], a1 = acc[ai][0][m][1] * rs + bv[0][1];
                    f32x4 b0 = acc[ai][1][m][0] * rs + bv[1][0], b1 = acc[ai][1][m][1] * rs + bv[1][1];
#pragma unroll
                    for (int j = 0; j < 4; ++j) { a0[j] *= sigmoidf_(b0[j]); a1[j] *= sigmoidf_(b1[j]); }
                    u32x4 w; w.x = cvt_pk_bf16(a0[0], a0[1]); w.y = cvt_pk_bf16(a0[2], a0[3]); w.z = cvt_pk_bf16(a1[0], a1[1]); w.w = cvt_pk_bf16(a1[2], a1[3]);
                    *(u32x4*)(base + (size_t)row * 512) = w;
                }
        } else {
            const int t = (u.pn - 4) >> 1;
            bf16_t* base = P + (size_t)(t + 1) * bufstride + ((u.pn - 4) & 1) * 256 + wc * 32 + 8 * fq;
            const bool gate = (t == 0) || (t == 4); const float sc = (t == 1) ? 0.125f : 1.0f;
#pragma unroll
            for (int ai = 0; ai < 2; ++ai)
#pragma unroll
                for (int m = 0; m < 4; ++m) {
                    const int row = row0 + ai * HALF + m * 16; const float rs = rstd[row];
#pragma unroll
                    for (int bj = 0; bj < 2; ++bj) {
                        f32x4 v0 = acc[ai][bj][m][0] * rs + bv[bj][0], v1 = acc[ai][bj][m][1] * rs + bv[bj][1];
                        if (gate) {
#pragma unroll
                            for (int j = 0; j < 4; ++j) { v0[j] *= sigmoidf_(v0[j]); v1[j] *= sigmoidf_(v1[j]); }
                        }
                        v0 = v0 * sc; v1 = v1 * sc;
                        u32x4 w; w.x = cvt_pk_bf16(v0[0], v0[1]); w.y = cvt_pk_bf16(v0[2], v0[3]); w.z = cvt_pk_bf16(v1[0], v1[1]); w.w = cvt_pk_bf16(v1[2], v1[3]);
                        *(u32x4*)(base + (size_t)row * 512 + bj * HALF) = w;
                    }
                }
        }
    }
};
struct EpiOut {
    static constexpr bool PERM = true, AFTER_DRAIN = false;
    const float* x; float* out; float* sspart;
    __device__ __forceinline__ void operator()(const f32x4 (&acc)[2][2][4][2], const Unit& u, int wr, int wc, int fr, int fq) const {
        const int row0 = u.pm * BM + wr * 64 + fr;
        const int col0 = u.pn * BM + wc * 32 + 8 * fq;
#pragma unroll
        for (int ai = 0; ai < 2; ++ai)
#pragma unroll
            for (int m = 0; m < 4; ++m) {
                const int row = row0 + ai * HALF + m * 16; float ss = 0.f;
#pragma unroll
                for (int bj = 0; bj < 2; ++bj) {
                    const size_t off = (size_t)row * 1024 + col0 + bj * HALF;
                    const f32x4 x0 = *(const f32x4*)(x + off), x1 = *(const f32x4*)(x + off + 4);
                    const f32x4 h0 = x0 + acc[ai][bj][m][0], h1 = x1 + acc[ai][bj][m][1];
                    *(f32x4*)(out + off) = h0; *(f32x4*)(out + off + 4) = h1;
                    ss += (h0[0] * h0[0] + h0[1] * h0[1]) + (h0[2] * h0[2] + h0[3] * h0[3]) + (h1[0] * h1[0] + h1[1] * h1[1]) + (h1[2] * h1[2] + h1[3] * h1[3]);
                }
                ss += __shfl_xor(ss, 16); ss += __shfl_xor(ss, 32);
                if (fq == 0) sspart[(size_t)row * 16 + u.pn * 4 + wc] = ss;
            }
    }
};

template <class Epi, class Sched, bool ALIGN_EPI = false, bool SP2 = false>
__device__ __forceinline__ void gemm_phase(PG8_LAS unsigned char* lds, const Gemm g, const Sched& S, const Epi& E) {
    const int tid = threadIdx.x, wid = __builtin_amdgcn_readfirstlane(tid >> 6), lane = tid & 63, wr = wid >> 2, wc = wid & 3, fr = lane & 15, fq = lane >> 4;
    const int K = g.K, nt = K / BK;
    unsigned voffA[2], voffB[2];
#pragma unroll
    for (int i = 0; i < 2; ++i) { int R, C; stage_rc(tid * 16 + i * 8192, R, C); const int Rb = Epi::PERM ? ((R & ~31) + perm32(R & 31)) : R;
        voffA[i] = (unsigned)(R * K + C) * 2u; voffB[i] = (unsigned)(Rb * K + C) * 2u; }
    const size_t kstep = (size_t)(BK * 2);
    const size_t hstep = (size_t)HALF * K * 2;
    const size_t tstep = 2 * hstep;
    const unsigned ldsw = (unsigned)wid * 1024u;
    const int aoff = lds_byte(wr * 64 + fr, fq * 8), boff = lds_byte(wc * 32 + fr, fq * 8);
#define PG8_SA(b, h) (((b) * 2 + (h)) * HTB)
#define PG8_SB(b, h) ((4 + (b) * 2 + (h)) * HTB)
#define PG8_STAGE(bufoff, gbase, voff) do { _Pragma("unroll") for (int _i = 0; _i < 2; ++_i) \
        __builtin_amdgcn_global_load_lds((const unsigned*)((const char*)(gbase) + (voff)[_i]), (PG8_LAS unsigned*)(lds + (bufoff) + ldsw + _i * 8192), 16, 0, 0); } while (0)
#define PG8_LDA(dst, b, h) do { _Pragma("unroll") for (int m = 0; m < 4; ++m) _Pragma("unroll") for (int k = 0; k < 2; ++k) dst[m][k] = *(const PG8_LAS bf16x8*)(lds + PG8_SA(b, h) + aoff + m * 2048 + k * 1024); } while (0)
#define PG8_LDB(dst, b, h) do { _Pragma("unroll") for (int n = 0; n < 2; ++n) _Pragma("unroll") for (int k = 0; k < 2; ++k) dst[n][k] = *(const PG8_LAS bf16x8*)(lds + PG8_SB(b, h) + boff + n * 2048 + k * 1024); } while (0)
#define PG8_MMA(ai, bj, At, Bt) do { __builtin_amdgcn_s_setprio(1); _Pragma("unroll") for (int m = 0; m < 4; ++m) _Pragma("unroll") for (int n = 0; n < 2; ++n) _Pragma("unroll") for (int k = 0; k < 2; ++k) \
        acc[ai][bj][m][n] = __builtin_amdgcn_mfma_f32_16x16x32_bf16(Bt[n][k], At[m][k], acc[ai][bj][m][n], 0, 0, 0); __builtin_amdgcn_s_setprio(0); } while (0)
#define PG8_WAIT_V(n) asm volatile("s_waitcnt vmcnt(" #n ")" ::: "memory")
#define PG8_WAIT_L(n) asm volatile("s_waitcnt lgkmcnt(" #n ")" ::: "memory")
#define PG8_BAR __builtin_amdgcn_s_barrier()
#define PG8_SCHED __builtin_amdgcn_sched_barrier(0)
    Unit cur, nxt; int ui = 0;
    if (!S.next(0, cur)) return;
    f32x4 acc[2][2][4][2];
#pragma unroll
    for (int a = 0; a < 2; ++a)
#pragma unroll
        for (int b = 0; b < 2; ++b)
#pragma unroll
            for (int m = 0; m < 4; ++m)
#pragma unroll
                for (int n = 0; n < 2; ++n) acc[a][b][m][n] = (f32x4){0.f, 0.f, 0.f, 0.f};
    bf16x8 At[4][2], B0[2][2], B1[2][2];
    const char* cA = (const char*)g.A + (size_t)cur.pm * tstep; const char* cB = (const char*)g.Bt + (size_t)cur.pn * tstep;
    S.a_ready(cur);
    if constexpr (SP2) {
        PG8_STAGE(PG8_SB(0, 0), cB, voffB); PG8_STAGE(PG8_SB(0, 1), cB + hstep, voffB); PG8_STAGE(PG8_SA(0, 0), cA, voffA); PG8_STAGE(PG8_SA(0, 1), cA + hstep, voffA);
        if (wr == 1) PG8_BAR;
        PG8_WAIT_V(2); PG8_BAR;
        PG8_STAGE(PG8_SB(1, 0), cB + kstep, voffB); PG8_STAGE(PG8_SA(1, 0), cA + kstep, voffA); PG8_STAGE(PG8_SB(1, 1), cB + hstep + kstep, voffB);
        PG8_WAIT_V(6); PG8_BAR;
    } else {
        PG8_STAGE(PG8_SB(0, 0), cB, voffB); PG8_STAGE(PG8_SA(0, 0), cA, voffA); PG8_STAGE(PG8_SB(0, 1), cB + hstep, voffB); PG8_STAGE(PG8_SA(0, 1), cA + hstep, voffA);
        if (wr == 1) PG8_BAR;
        PG8_WAIT_V(4); PG8_BAR;
        PG8_STAGE(PG8_SB(1, 0), cB + kstep, voffB); PG8_STAGE(PG8_SA(1, 0), cA + kstep, voffA); PG8_STAGE(PG8_SB(1, 1), cB + hstep + kstep, voffB);
        PG8_WAIT_V(6); PG8_BAR;
    }
    for (;;) {
        const bool has_next = S.next(ui + 1, nxt);
        const char* nA = has_next ? (const char*)g.A + (size_t)nxt.pm * tstep : cA; const char* nB = has_next ? (const char*)g.Bt + (size_t)nxt.pn * tstep : cB;
        for (int t = 0; t < nt; t += 2) {
            const bool last = (t == nt - 2);
            const char* a1 = cA + (size_t)(t + 1) * kstep;
            const char* a2 = last ? nA : cA + (size_t)(t + 2) * kstep; const char* b2 = last ? nB : cB + (size_t)(t + 2) * kstep;
            const char* a3 = a2 + kstep; const char* b3 = b2 + kstep;
            if (last && has_next) S.a_ready(nxt);
            if constexpr (SP2) {
            PG8_LDB(B0, 0, 0); PG8_LDB(B1, 0, 1); PG8_SCHED; PG8_LDA(At, 0, 0); PG8_STAGE(PG8_SA(1, 1), a1 + hstep, voffA);
            PG8_WAIT_V(8); PG8_WAIT_L(0); PG8_BAR; PG8_MMA(0, 0, At, B0); PG8_MMA(0, 1, At, B1); PG8_BAR; PG8_SCHED;
            PG8_LDA(At, 0, 1); PG8_STAGE(PG8_SB(0, 0), b2, voffB); PG8_STAGE(PG8_SB(0, 1), b2 + hstep, voffB); PG8_STAGE(PG8_SA(0, 0), a2, voffA);
            PG8_WAIT_V(8); PG8_WAIT_L(0); PG8_BAR; PG8_MMA(1, 0, At, B0); PG8_MMA(1, 1, At, B1); PG8_BAR; PG8_SCHED;
            PG8_LDB(B0, 1, 0); PG8_LDB(B1, 1, 1); PG8_SCHED; PG8_LDA(At, 1, 0); PG8_STAGE(PG8_SA(0, 1), a2 + hstep, voffA);
            PG8_WAIT_V(8); PG8_WAIT_L(0); PG8_BAR; PG8_MMA(0, 0, At, B0); PG8_MMA(0, 1, At, B1); PG8_BAR; PG8_SCHED;
            PG8_LDA(At, 1, 1); PG8_STAGE(PG8_SB(1, 0), b3, voffB); PG8_STAGE(PG8_SB(1, 1), b3 + hstep, voffB); PG8_STAGE(PG8_SA(1, 0), a3, voffA);
            PG8_WAIT_V(8); PG8_WAIT_L(0); PG8_BAR; PG8_MMA(1, 0, At, B0); PG8_MMA(1, 1, At, B1); PG8_BAR; PG8_SCHED;
            } else {
            PG8_LDB(B0, 0, 0); PG8_SCHED; PG8_LDA(At, 0, 0); PG8_STAGE(PG8_SA(1, 1), a1 + hstep, voffA);
            PG8_WAIT_L(8); PG8_BAR; PG8_WAIT_L(0); PG8_MMA(0, 0, At, B0); PG8_BAR; PG8_SCHED;
            PG8_LDB(B1, 0, 1); PG8_STAGE(PG8_SB(0, 0), b2, voffB);
            PG8_BAR; PG8_WAIT_L(0); PG8_MMA(0, 1, At, B1); PG8_BAR;
            PG8_LDA(At, 0, 1); PG8_STAGE(PG8_SA(0, 0), a2, voffA);
            PG8_BAR; PG8_WAIT_L(0); PG8_MMA(1, 0, At, B0); PG8_BAR; PG8_SCHED;
            PG8_STAGE(PG8_SB(0, 1), b2 + hstep, voffB);
            PG8_WAIT_V(6); PG8_BAR; PG8_MMA(1, 1, At, B1); PG8_BAR;
            PG8_LDB(B0, 1, 0); PG8_SCHED; PG8_LDA(At, 1, 0); PG8_STAGE(PG8_SA(0, 1), a2 + hstep, voffA);
            PG8_WAIT_L(8); PG8_BAR; PG8_WAIT_L(0); PG8_MMA(0, 0, At, B0); PG8_BAR; PG8_SCHED;
            PG8_LDB(B1, 1, 1); PG8_STAGE(PG8_SB(1, 0), b3, voffB);
            PG8_BAR; PG8_WAIT_L(0); PG8_MMA(0, 1, At, B1); PG8_BAR;
            PG8_LDA(At, 1, 1); PG8_STAGE(PG8_SA(1, 0), a3, voffA);
            PG8_BAR; PG8_WAIT_L(0); PG8_MMA(1, 0, At, B0); PG8_BAR; PG8_SCHED;
            PG8_STAGE(PG8_SB(1, 1), b3 + hstep, voffB);
            PG8_WAIT_V(6); PG8_BAR; PG8_MMA(1, 1, At, B1); PG8_BAR;
            }
        }
        if constexpr (ALIGN_EPI) { if (wr == 0) PG8_BAR; }
        if constexpr (!Epi::AFTER_DRAIN) { E(acc, cur, wr, wc, fr, fq); S.done(cur); }
        if (!has_next) break;
#pragma unroll
        for (int a = 0; a < 2; ++a)
#pragma unroll
            for (int b = 0; b < 2; ++b)
#pragma unroll
                for (int m = 0; m < 4; ++m)
#pragma unroll
                    for (int n = 0; n < 2; ++n) acc[a][b][m][n] = (f32x4){0.f, 0.f, 0.f, 0.f};
        cur = nxt; cA = nA; cB = nB; ++ui;
        if constexpr (ALIGN_EPI) { if (wr == 1) PG8_BAR; }
    }
    PG8_WAIT_V(0);
    if constexpr (!ALIGN_EPI) { if (wr == 0) PG8_BAR; }
    PG8_BAR;
    if constexpr (Epi::AFTER_DRAIN) { E.fused(acc, cur, wr, wc, fr, fq, lds, wid, lane); S.done(cur); }
#undef PG8_SA
#undef PG8_SB
#undef PG8_STAGE
#undef PG8_LDA
#undef PG8_LDB
#undef PG8_MMA
#undef PG8_WAIT_V
#undef PG8_WAIT_L
#undef PG8_BAR
#undef PG8_SCHED
}
}

#ifndef MK_LAUNCHES
#define MK_LAUNCHES 1
#endif
#ifndef REP_P0
#define REP_P0 1
#endif
#ifndef REP_P1
#define REP_P1 1
#endif
#ifndef REP_P3
#define REP_P3 1
#endif
typedef unsigned short bf16;
typedef short bf16x8 __attribute__((ext_vector_type(8)));
typedef short s16x4 __attribute__((ext_vector_type(4)));
typedef float f32x4 __attribute__((ext_vector_type(4)));
typedef float f32x16 __attribute__((ext_vector_type(16)));
typedef unsigned u32x4 __attribute__((ext_vector_type(4)));
typedef unsigned u32x2 __attribute__((ext_vector_type(2)));
#define LASX __attribute__((address_space(3)))

constexpr int BATCH = 2, SEQ = 8192, D = 1024, M = BATCH * SEQ, NPROJ = 3584;
constexpr float EPS = 1e-6f;
constexpr size_t MiB = 1u << 20;
constexpr size_t WS_WIN = 1 * MiB, WS_WOUT = 9 * MiB, WS_PW = 11 * MiB, WS_BIAS = 12 * MiB, WS_RSTD = 12 * MiB + 65536, WS_SSP = 13 * MiB;
constexpr size_t WS_XB = 16 * MiB, WS_P = 48 * MiB, WS_Y = 144 * MiB, WS_END = 176 * MiB;
constexpr size_t PBUF = (size_t)M * 512;
constexpr int LDS_BYTES = 147456;
constexpr int NTHREADS = 512, NWAVES = 8;

__device__ __forceinline__ float bf_lo(unsigned u) { return __builtin_bit_cast(float, u << 16); }
__device__ __forceinline__ float bf_hi(unsigned u) { return __builtin_bit_cast(float, u & 0xffff0000u); }
__device__ __forceinline__ unsigned pkbf(float lo, float hi) { unsigned r; asm("v_cvt_pk_bf16_f32 %0, %1, %2" : "=v"(r) : "v"(lo), "v"(hi)); return r; }
__device__ __forceinline__ float wave_sum(float v) {
#pragma unroll
    for (int o = 1; o < 64; o <<= 1) v += __shfl_xor(v, o);
    return v;
}
#define LDS_WAIT() asm volatile("s_waitcnt lgkmcnt(0)" ::: "memory")

__device__ __forceinline__ int colmap(int n) {
    if (n >= 1024) return n;
    if (n < 512) return 256 * (n >> 7) + (n & 127);
    n -= 512; return 256 * (n >> 7) + 128 + (n & 127);
}
__device__ __forceinline__ void transpose_item(const float* __restrict__ W, const float* __restrict__ g, int K, int N, bf16* WT, bool remap, float* scr, int item, int lane) {
    const int nblk = N / 32, kb = item / nblk, nb = item % nblk, k0 = 64 * kb, n0 = 32 * nb;
#pragma unroll 8
    for (int i = 0; i < 32; ++i) { const int kk = 2 * i + (lane >> 5); float v = W[(size_t)(k0 + kk) * N + n0 + (lane & 31)]; if (g) v *= g[k0 + kk]; scr[kk * 33 + (lane & 31)] = v; }
    LDS_WAIT();
    const int c = lane & 7; const int row_off = remap ? colmap(n0) : n0;
#pragma unroll
    for (int j = 0; j < 4; ++j) { const int n = (lane >> 3) + 8 * j; const float* s = scr + (8 * c) * 33 + n;
        u32x4 o; o.x = pkbf(s[0 * 33], s[1 * 33]); o.y = pkbf(s[2 * 33], s[3 * 33]); o.z = pkbf(s[4 * 33], s[5 * 33]); o.w = pkbf(s[6 * 33], s[7 * 33]);
        *(u32x4*)(WT + (size_t)(row_off + n) * K + k0 + 8 * c) = o; }
    LDS_WAIT();
}

struct Args { const float* in[15]; float* out; unsigned char* ws; int ph_lo, ph_hi; int pad0, pad1; };

__device__ __forceinline__ void p0_prologue(unsigned char* lds, const Args& a, int G) {
    const int tid = threadIdx.x, lane = tid & 63, wave = tid >> 6;
    const float* x = a.in[0]; const float* ln_g = a.in[1]; const float* w_in = a.in[2]; const float* b_in = a.in[3];
    const float* pw_w = a.in[8]; const float* w_out = a.in[13];
    bf16* Wt_in = (bf16*)(a.ws + WS_WIN); bf16* Wt_out = (bf16*)(a.ws + WS_WOUT); bf16* Wt_pw = (bf16*)(a.ws + WS_PW);
    float* biasp = (float*)(a.ws + WS_BIAS); float* rstd = (float*)(a.ws + WS_RSTD); bf16* XB = (bf16*)(a.ws + WS_XB);
    float* scr = (float*)(lds + wave * 16384);
    const int gw = blockIdx.x * NWAVES + wave, NGW = G * NWAVES;
    constexpr int I_IN = (D / 64) * (NPROJ / 32), I_OUT = (D / 64) * (D / 32), I_PW = (512 / 64) * (512 / 32);
    for (int it = gw; it < I_IN + I_OUT + I_PW; it += NGW) {
        int r = it;
        if (r < I_IN) { transpose_item(w_in, ln_g, D, NPROJ, Wt_in, true, scr, r, lane); continue; } r -= I_IN;
        if (r < I_OUT) { transpose_item(w_out, nullptr, D, D, Wt_out, false, scr, r, lane); continue; } r -= I_OUT;
        transpose_item(pw_w, nullptr, 512, 512, Wt_pw, false, scr, r, lane);
    }
    for (int n = blockIdx.x * NTHREADS + tid; n < NPROJ; n += G * NTHREADS) biasp[colmap(n)] = b_in[n];
    for (int m = gw; m < M; m += NGW) {
        const f32x4* xr = (const f32x4*)(x + (size_t)m * D) + lane;
        f32x4 v[4]; float s = 0.f;
#pragma unroll
        for (int j = 0; j < 4; ++j) { v[j] = xr[64 * j]; s += (v[j].x * v[j].x + v[j].y * v[j].y) + (v[j].z * v[j].z + v[j].w * v[j].w); }
        s = wave_sum(s);
        if (lane == 0) rstd[m] = 1.0f / sqrtf(s * (1.0f / D) + EPS);
        u32x2* o8 = (u32x2*)(XB + (size_t)m * D) + lane;
#pragma unroll
        for (int j = 0; j < 4; ++j) { u32x2 o; o.x = pkbf(v[j].x, v[j].y); o.y = pkbf(v[j].z, v[j].w); o8[64 * j] = o; }
    }
}

constexpr int CV_W_PITCH = 144, CV_W_BYTES = 512 * CV_W_PITCH;
constexpr int CV_VN_OFF = CV_W_BYTES, CV_VN_PITCH = 1040;
static_assert(CV_VN_OFF + 32 * CV_VN_PITCH <= LDS_BYTES && 62 * 1024 <= CV_W_BYTES, "conv LDS map");

__device__ __forceinline__ void conv_unit(unsigned char* lds, int unit, const bf16* __restrict__ U, const bf16* __restrict__ ZC, const float* __restrict__ dw_w, const float* __restrict__ dw_b,
                                          const float* __restrict__ cln_g, const float* __restrict__ cln_b, const bf16* __restrict__ pw_t, const float* __restrict__ pw_b,
                                          const float* __restrict__ gn_g, bf16* __restrict__ Y) {
    const int tid = threadIdx.x, lane = tid & 63, w = tid >> 6;
    const int b = unit >> 8, tok0 = (unit & 255) * 32;
    const size_t rowbase = (size_t)b * SEQ;
    for (int idx = tid; idx < 62 * 64; idx += NTHREADS) {
        const int row = idx >> 6, ch = idx & 63, t = tok0 - 15 + row;
        u32x4 v = {0u, 0u, 0u, 0u};
        if (t >= 0 && t < SEQ) v = *(const u32x4*)(U + (rowbase + t) * 512 + ch * 8);
        *(u32x4*)(lds + row * 1024 + ch * 16) = v;
    }
    const int cp = tid & 255, th = tid >> 8;
    float w0[31], w1[31];
#pragma unroll
    for (int j = 0; j < 31; ++j) { const float2 ww = *(const float2*)(dw_w + j * 512 + 2 * cp); w0[j] = ww.x; w1[j] = ww.y; }
    float a0[16], a1[16];
    { const float2 bb = *(const float2*)(dw_b + 2 * cp);
#pragma unroll
      for (int o = 0; o < 16; ++o) { a0[o] = bb.x; a1[o] = bb.y; } }
    __syncthreads();
#pragma unroll
    for (int i = 0; i < 46; ++i) {
        const unsigned uu = *(const unsigned*)(lds + (16 * th + i) * 1024 + cp * 4);
        const float u0 = bf_lo(uu), u1 = bf_hi(uu);
#pragma unroll
        for (int j = 0; j < 31; ++j) { const int o = i - j; if (o >= 0 && o < 16) { a0[o] = fmaf(w0[j], u0, a0[o]); a1[o] = fmaf(w1[j], u1, a1[o]); } }
        if ((i & 7) == 7) __builtin_amdgcn_sched_barrier(0);
    }
#pragma unroll
    for (int o = 0; o < 16; ++o) *(unsigned*)(lds + CV_VN_OFF + (16 * th + o) * CV_VN_PITCH + cp * 4) = pkbf(a0[o], a1[o]);
    __syncthreads();
    u32x4 wreg[8];
    const int wrow = tid >> 3, wch = tid & 7;
#define CV_LOADW(kc) do { unsigned wo_ = (unsigned)(wrow * 1024 + wch * 16 + (kc) * 128); asm volatile("" : "+v"(wo_)); \
        _Pragma("unroll") for (int i = 0; i < 8; ++i) wreg[i] = *(const u32x4*)((const unsigned char*)pw_t + (wo_ + (unsigned)i * 65536u)); } while (0)
#define CV_STOREW() do { _Pragma("unroll") for (int i = 0; i < 8; ++i) *(u32x4*)(lds + (wrow + 64 * i) * CV_W_PITCH + wch * 16) = wreg[i]; } while (0)
    CV_LOADW(0);
    {
        const f32x4 g0 = *(const f32x4*)(cln_g + 8 * lane), g1 = *(const f32x4*)(cln_g + 8 * lane + 4);
        const f32x4 c0 = *(const f32x4*)(cln_b + 8 * lane), c1 = *(const f32x4*)(cln_b + 8 * lane + 4);
#pragma unroll
        for (int tt = 0; tt < 4; ++tt) {
            unsigned char* p = lds + CV_VN_OFF + (4 * w + tt) * CV_VN_PITCH + lane * 16;
            const u32x4 raw = *(const u32x4*)p;
            float v[8] = {bf_lo(raw.x), bf_hi(raw.x), bf_lo(raw.y), bf_hi(raw.y), bf_lo(raw.z), bf_hi(raw.z), bf_lo(raw.w), bf_hi(raw.w)};
            float s = 0.f;
#pragma unroll
            for (int e = 0; e < 8; ++e) s += v[e];
            const float mean = wave_sum(s) * (1.0f / 512.0f);
            float q = 0.f;
#pragma unroll
            for (int e = 0; e < 8; ++e) { v[e] -= mean; q += v[e] * v[e]; }
            const float rstd = 1.0f / sqrtf(wave_sum(q) * (1.0f / 512.0f) + EPS);
            const float gg[8] = {g0[0], g0[1], g0[2], g0[3], g1[0], g1[1], g1[2], g1[3]};
            const float cc[8] = {c0[0], c0[1], c0[2], c0[3], c1[0], c1[1], c1[2], c1[3]};
#pragma unroll
            for (int e = 0; e < 8; ++e) { const float n = v[e] * rstd * gg[e] + cc[e]; v[e] = n * pg8::sigmoidf_(n); }
            u32x4 o; o.x = pkbf(v[0], v[1]); o.y = pkbf(v[2], v[3]); o.z = pkbf(v[4], v[5]); o.w = pkbf(v[6], v[7]);
            *(u32x4*)p = o;
        }
    }
    CV_STOREW();
    __syncthreads();
    const int r32 = lane & 31, h2 = lane >> 5;
    f32x16 acc[2];
#pragma unroll
    for (int a = 0; a < 2; ++a)
#pragma unroll
        for (int e = 0; e < 16; ++e) acc[a][e] = 0.f;
    for (int kc = 0; kc < 8; ++kc) {
        if (kc < 7) CV_LOADW(kc + 1);
#pragma unroll
        for (int s = 0; s < 4; ++s) {
            const bf16x8 bfr = *(const bf16x8*)(lds + CV_VN_OFF + r32 * CV_VN_PITCH + (kc * 64 + s * 16 + 8 * h2) * 2);
#pragma unroll
            for (int a = 0; a < 2; ++a) {
                const bf16x8 afr = *(const bf16x8*)(lds + (64 * w + 32 * a + r32) * CV_W_PITCH + (s * 16 + 8 * h2) * 2);
                acc[a] = __builtin_amdgcn_mfma_f32_32x32x16_bf16(afr, bfr, acc[a], 0, 0, 0);
            }
        }
        __syncthreads();
        if (kc < 7) { CV_STOREW(); __syncthreads(); }
    }
#undef CV_LOADW
#undef CV_STOREW
    const size_t row = rowbase + tok0 + r32;
    float ss = 0.f;
#pragma unroll
    for (int a = 0; a < 2; ++a)
#pragma unroll
        for (int rg = 0; rg < 4; ++rg) {
            const f32x4 pb = *(const f32x4*)(pw_b + 64 * w + 32 * a + 8 * rg + 4 * h2);
#pragma unroll
            for (int j = 0; j < 4; ++j) { const float v = acc[a][4 * rg + j] + pb[j]; acc[a][4 * rg + j] = v; ss += v * v; }
        }
    ss += __shfl_xor(ss, 32);
    const float rstd = 1.0f / sqrtf(ss * (1.0f / 64.0f) + EPS);
#pragma unroll
    for (int a = 0; a < 2; ++a)
#pragma unroll
        for (int rg = 0; rg < 4; ++rg) {
            const int oc0 = 64 * w + 32 * a + 8 * rg + 4 * h2;
            const f32x4 g = *(const f32x4*)(gn_g + oc0);
            const u32x2 z = *(const u32x2*)(ZC + row * 512 + oc0);
            u32x2 o;
            o.x = pkbf(acc[a][4 * rg + 0] * rstd * g[0] * bf_lo(z.x), acc[a][4 * rg + 1] * rstd * g[1] * bf_hi(z.x));
            o.y = pkbf(acc[a][4 * rg + 2] * rstd * g[2] * bf_lo(z.y), acc[a][4 * rg + 3] * rstd * g[3] * bf_hi(z.y));
            *(u32x2*)(Y + row * 1024 + oc0) = o;
        }
}

constexpr int AT_RPB_OFF = 2 * 8 * 64 * 128;
static_assert(AT_RPB_OFF + 2 * 465 * 4 <= LDS_BYTES - 16, "attention LDS map");
__device__ __forceinline__ s16x4 vtr(const unsigned char* p) {
    typedef short v4i16_t __attribute__((ext_vector_type(4)));
    return __builtin_bit_cast(s16x4, __builtin_amdgcn_ds_read_tr16_b64_v4i16((LASX v4i16_t*)p));
}
__device__ __forceinline__ void attn_unit(unsigned char* lds, int unit, const bf16* __restrict__ Q, const bf16* __restrict__ K, const bf16* __restrict__ V, const bf16* __restrict__ ZA,
                                          const float* __restrict__ rpb, const float* __restrict__ gn_g, bf16* __restrict__ Y) {
    const int tid = threadIdx.x, lane = tid & 63, w = tid >> 6;
    const int b = unit >> 9, hp = (unit >> 7) & 3, r = unit & 127;
    const int rs = min(max(r - 4, 0), 120);
    const size_t rowbase = (size_t)b * SEQ;
    for (int idx = tid; idx < 8192; idx += NTHREADS) {
        const int tr = idx >> 4, c16 = idx & 15, i = tr >> 6, tok = tr & 63, head = c16 >> 3, ch = c16 & 7;
        const u32x4 v = *(const u32x4*)(V + (rowbase + (size_t)(rs + i) * 64 + tok) * 512 + hp * 128 + c16 * 8);
        *(u32x4*)(lds + head * 65536 + tr * 128 + (((ch >> 1) ^ ((tok >> 1) & 3)) << 5) + ((ch & 1) << 4)) = v;
    }
    for (int idx = tid; idx < 930; idx += NTHREADS) ((float*)(lds + AT_RPB_OFF))[idx] = rpb[hp * 930 + idx];
    __syncthreads();
    const int hl = w >> 2, c = w & 3, h = 2 * hp + hl;
    const int wc0 = (c == 0) ? 0 : (c == 1) ? 8 : (c == 2) ? 24 : 32;
    const int l16 = lane & 15, g = lane >> 4;
    const size_t tq = rowbase + (size_t)r * 64 + 16 * c + l16;
    const bf16x8 qf0 = *(const bf16x8*)(Q + tq * 512 + h * 64 + 8 * g), qf1 = *(const bf16x8*)(Q + tq * 512 + h * 64 + 32 + 8 * g);
    f32x4 st[8][2];
#pragma unroll
    for (int i = 0; i < 8; ++i)
#pragma unroll
        for (int hh = 0; hh < 2; ++hh) {
            const bf16* kp = K + (rowbase + (size_t)(rs + i) * 64 + wc0 + 16 * hh + l16) * 512 + h * 64 + 8 * g;
            const bf16x8 k0 = *(const bf16x8*)kp, k1 = *(const bf16x8*)(kp + 32);
            f32x4 z = {0.f, 0.f, 0.f, 0.f};
            z = __builtin_amdgcn_mfma_f32_16x16x32_bf16(k0, qf0, z, 0, 0, 0);
            z = __builtin_amdgcn_mfma_f32_16x16x32_bf16(k1, qf1, z, 0, 0, 0);
            st[i][hh] = z;
        }
    const int wq = 16 * c + l16, cs = min(max(wq - 8, 0), 48);
    const float* tbl = (const float*)(lds + AT_RPB_OFF) + hl * 465;
    float mx = -1e30f;
#pragma unroll
    for (int i = 0; i < 8; ++i) {
        const int rowoff = (rs + i - r + 7) * 31 - wq + 15;
#pragma unroll
        for (int hh = 0; hh < 2; ++hh)
#pragma unroll
            for (int j = 0; j < 4; ++j) {
                const int kc = wc0 + 16 * hh + 4 * g + j;
                const bool inw = (kc >= cs) && (kc < cs + 16);
                const float bias = tbl[inw ? rowoff + kc : 0];
                const float s = inw ? st[i][hh][j] + bias : -1e30f;
                st[i][hh][j] = s; mx = fmaxf(mx, s);
            }
    }
    mx = fmaxf(mx, __shfl_xor(mx, 16)); mx = fmaxf(mx, __shfl_xor(mx, 32));
    float sum = 0.f;
#pragma unroll
    for (int i = 0; i < 8; ++i)
#pragma unroll
        for (int hh = 0; hh < 2; ++hh)
#pragma unroll
            for (int j = 0; j < 4; ++j) { const float p = __builtin_amdgcn_exp2f((st[i][hh][j] - mx) * 1.4426950408889634f); st[i][hh][j] = p; sum += p; }
    sum += __shfl_xor(sum, 16); sum += __shfl_xor(sum, 32);
    const unsigned char* vb = lds + hl * 65536;
    const int qq = l16 >> 2, pp = l16 & 3;
    const int key0 = wc0 + 4 * g + qq, sw = (key0 >> 1) & 3;
    f32x4 o[4];
#pragma unroll
    for (int ht = 0; ht < 4; ++ht) o[ht] = (f32x4){0.f, 0.f, 0.f, 0.f};
#pragma unroll
    for (int i = 0; i < 8; ++i) {
        u32x4 pw; pw.x = pkbf(st[i][0][0], st[i][0][1]); pw.y = pkbf(st[i][0][2], st[i][0][3]); pw.z = pkbf(st[i][1][0], st[i][1][1]); pw.w = pkbf(st[i][1][2], st[i][1][3]);
        const bf16x8 pf = __builtin_bit_cast(bf16x8, pw);
#pragma unroll
        for (int ht = 0; ht < 4; ++ht) {
            const unsigned char* a0 = vb + (i * 64 + key0) * 128 + ((ht ^ sw) << 5) + 8 * pp;
            const s16x4 lo = vtr(a0), hi = vtr(a0 + 16 * 128);
            const bf16x8 vf = __builtin_shufflevector(lo, hi, 0, 1, 2, 3, 4, 5, 6, 7);
            o[ht] = __builtin_amdgcn_mfma_f32_16x16x32_bf16(vf, pf, o[ht], 0, 0, 0);
        }
    }
    const float inv = 1.0f / sum;
    float ss = 0.f;
#pragma unroll
    for (int ht = 0; ht < 4; ++ht)
#pragma unroll
        for (int j = 0; j < 4; ++j) { const float v = o[ht][j] * inv; o[ht][j] = v; ss += v * v; }
    ss += __shfl_xor(ss, 16); ss += __shfl_xor(ss, 32);
    const float rstd = 1.0f / sqrtf(ss * (1.0f / 64.0f) + EPS);
#pragma unroll
    for (int ht = 0; ht < 4; ++ht) {
        const int ch = h * 64 + 16 * ht + 4 * g;
        const f32x4 gg = *(const f32x4*)(gn_g + ch);
        const u32x2 z = *(const u32x2*)(ZA + tq * 512 + ch);
        u32x2 ov;
        ov.x = pkbf(o[ht][0] * rstd * gg[0] * bf_lo(z.x), o[ht][1] * rstd * gg[1] * bf_hi(z.x));
        ov.y = pkbf(o[ht][2] * rstd * gg[2] * bf_lo(z.y), o[ht][3] * rstd * gg[3] * bf_hi(z.y));
        *(u32x2*)(Y + tq * 1024 + 512 + ch) = ov;
    }
    __syncthreads();
}

#define LAS __attribute__((address_space(3)))
#define XB_TMO      128
#define XB_XCNT(j)  (256  + 64 * (j))
#define XB_XSUB(j)  (1280 + 64 * (j))
#define XB_XGEN(j)  (2304 + 64 * (j))
#define XB_TOP      3328
#define XB_TOPGEN   3392
#define XCD_BAR_WORDS 3456
#define XB_SPIN_CAP (1u << 18)

__device__ __forceinline__ unsigned xb_ld(unsigned* p)              { return __hip_atomic_load(p, __ATOMIC_RELAXED, __HIP_MEMORY_SCOPE_AGENT); }
__device__ __forceinline__ unsigned xb_add(unsigned* p, unsigned v) { return __hip_atomic_fetch_add(p, v, __ATOMIC_RELAXED, __HIP_MEMORY_SCOPE_AGENT); }
__device__ __forceinline__ unsigned xb_xcc_id() { return (unsigned)__builtin_amdgcn_s_getreg((3 << 11) | 20) & 0xFu; }
#define XB_SPIN(cond, bar) do { unsigned _sp = 0; while (cond) { __builtin_amdgcn_s_sleep(1); \
    if ((++_sp & 255u) == 0u) { if (xb_ld(&(bar)[XB_TMO])) break; if (_sp > XB_SPIN_CAP) { atomicAdd(&(bar)[XB_TMO], 1u); break; } } } } while (0)

struct XcdBarrier {
    unsigned* bar; unsigned x;
    volatile LAS unsigned* st;
};

__device__ __forceinline__ XcdBarrier xcd_barrier_post(unsigned* bar, volatile LAS unsigned* st) {
    XcdBarrier b; b.bar = bar; b.x = xb_xcc_id(); b.st = st;
    if (threadIdx.x == 0) (void)xb_add(&bar[XB_XCNT(b.x)], 1u);
    return b;
}
__device__ __forceinline__ void xcd_barrier_complete(unsigned* bar, unsigned x, unsigned& nloc, unsigned& nx) {
    const unsigned G = gridDim.x * gridDim.y * gridDim.z;
    unsigned sum, cnt, mine, sp = 0u;
    for (;;) {
        sum = 0u; cnt = 0u; mine = 0u;
#pragma unroll
        for (unsigned j = 0; j < 16; ++j) { const unsigned c = xb_ld(&bar[XB_XCNT(j)]); sum += c; cnt += (c > 0u) ? 1u : 0u; mine = (j == x) ? c : mine; }
        if (sum == G) break;
        __builtin_amdgcn_s_sleep(1);
        if ((++sp & 255u) == 0u) { if (xb_ld(&bar[XB_TMO])) break; if (sp > XB_SPIN_CAP) { atomicAdd(&bar[XB_TMO], 1u); break; } }
    }
    nloc = mine > 0u ? mine : 1u; nx = cnt > 0u ? cnt : 1u;
}

__device__ __forceinline__ void xcd_barrier(const XcdBarrier& b) {
    asm volatile("s_waitcnt vmcnt(0)" ::: "memory");
    __syncthreads();
    if (threadIdx.x == 0) {
        unsigned* bar = b.bar;
        __builtin_amdgcn_s_waitcnt(0);
        unsigned nloc = b.st[0], nx = b.st[1];
        if (nloc == 0u) { xcd_barrier_complete(bar, b.x, nloc, nx); b.st[0] = nloc; b.st[1] = nx; }
        const unsigned old = xb_add(&bar[XB_XSUB(b.x)], 1u);
        const unsigned gen = old / nloc;
        if (old + 1u == (gen + 1u) * nloc) {
            __builtin_amdgcn_fence(__ATOMIC_RELEASE, "agent");
            asm volatile("s_waitcnt vmcnt(0)" ::: "memory");
            const unsigned og = xb_add(&bar[XB_TOP], 1u);
            const unsigned tg = og / nx;
            if (og + 1u == (tg + 1u) * nx) xb_add(&bar[XB_TOPGEN], 1u);
            else XB_SPIN(xb_ld(&bar[XB_TOPGEN]) == tg, bar);
            __builtin_amdgcn_fence(__ATOMIC_ACQUIRE, "agent");
            xb_add(&bar[XB_XGEN(b.x)], 1u);
            asm volatile("s_waitcnt vmcnt(0)" ::: "memory");
        } else {
            XB_SPIN(xb_ld(&bar[XB_XGEN(b.x)]) == gen, bar);
            __builtin_amdgcn_fence(__ATOMIC_ACQUIRE, "agent");
            asm volatile("s_waitcnt vmcnt(0)" ::: "memory");
        }
    }
    __syncthreads();
}

__global__ void __launch_bounds__(NTHREADS, 2) fwd_mega(Args a) {
    extern __shared__ __attribute__((aligned(16))) unsigned char lds[];
    cg::grid_group grid = cg::this_grid();
    volatile LAS unsigned* bst = (volatile LAS unsigned*)((LAS unsigned char*)lds + LDS_BYTES - 16);
    if (threadIdx.x < 4) bst[threadIdx.x] = 0u;
    __syncthreads();
    XcdBarrier bar = xcd_barrier_post((unsigned*)a.ws, bst);
    const int G = gridDim.x, tid = threadIdx.x, lane = tid & 63, wave = tid >> 6;
    const int lo = a.ph_lo, hi = a.ph_hi;
    unsigned char* ws = a.ws;
    bf16* P = (bf16*)(ws + WS_P); bf16* Yb = (bf16*)(ws + WS_Y);
#define IN(k) (lo <= (k) && (k) < hi)
#define SEAM(k) do { if (IN(k) && IN((k) + 1)) { if (lo < 0) grid.sync(); xcd_barrier(bar); } } while (0)
#ifndef SKIP_P0
    if (IN(0)) p0_prologue(lds, a, G);
#if REP_P0 > 1
    if (IN(0)) p0_prologue(lds, a, G);
#endif
#endif
    SEAM(0);
#ifndef SKIP_P1
    if (IN(1)) {
        pg8::Gemm g{(const pg8::bf16_t*)(ws + WS_XB), (const pg8::bf16_t*)(ws + WS_WIN), M, NPROJ, D};
        pg8::RepOrder<REP_P1> S; S.init(M, NPROJ, G, (int)blockIdx.x);
        pg8::EpiIn E{(pg8::bf16_t*)P, (const float*)(ws + WS_BIAS), (const float*)(ws + WS_RSTD), PBUF};
        pg8::gemm_phase<pg8::EpiIn, pg8::RepOrder<REP_P1>, true, true>((PG8_LAS unsigned char*)lds, g, S, E);
    }
#endif
    SEAM(1);
    if (IN(2)) {
        const int vcu = (G % 8 == 0) ? (int)(blockIdx.x % 8) * (G / 8) + (int)blockIdx.x / 8 : (int)blockIdx.x;
#ifndef REP_CONV
#define REP_CONV 1
#endif
#ifndef REP_ATTN
#define REP_ATTN 1
#endif
        for (int u = vcu; u < 512 + 1024; u += G) {
#ifndef SKIP_CONV
            if (u < 512) conv_unit(lds, u, P, P + PBUF, a.in[4], a.in[5], a.in[6], a.in[7], (const bf16*)(ws + WS_PW), a.in[9], a.in[11], Yb);
#endif
#ifndef SKIP_ATTN
            if (u >= 512) attn_unit(lds, u - 512, P + 2 * PBUF, P + 3 * PBUF, P + 4 * PBUF, P + 5 * PBUF, a.in[10], a.in[12], Yb);
#endif
        }
    }
    SEAM(2);
#ifndef SKIP_P3
    if (IN(3)) {
        pg8::Gemm g{(const pg8::bf16_t*)Yb, (const pg8::bf16_t*)(ws + WS_WOUT), M, D, D};
        pg8::RepOrder<REP_P3> S; S.init(M, D, G, (int)blockIdx.x);
        pg8::EpiOut E{a.in[0], a.out, (float*)(ws + WS_SSP)};
        pg8::gemm_phase<pg8::EpiOut, pg8::RepOrder<REP_P3>, true, true>((PG8_LAS unsigned char*)lds, g, S, E);
    }
#endif
    SEAM(3);
    if (IN(4)) {
        const float* ssp = (const float*)(ws + WS_SSP); const float* fg = a.in[14];
        f32x4 gv[4];
#pragma unroll
        for (int j = 0; j < 4; ++j) gv[j] = *((const f32x4*)fg + lane + 64 * j);
        for (int m = blockIdx.x * NWAVES + wave; m < M; m += G * NWAVES) {
            float s = (lane < 16) ? ssp[(size_t)m * 16 + lane] : 0.f;
            s = wave_sum(s);
            const float rstd = 1.0f / sqrtf(s * (1.0f / D) + EPS);
            f32x4* o = (f32x4*)(a.out + (size_t)m * D) + lane;
#pragma unroll
            for (int j = 0; j < 4; ++j) { f32x4 v = o[64 * j]; v = v * rstd * gv[j]; o[64 * j] = v; }
        }
    }
#undef IN
#undef SEAM
}

extern "C" void kernel_launch(void* const* d_in, const int* in_sizes, int n_in, void* d_out, int out_size, void* d_ws, size_t ws_size, hipStream_t stream) {
    static int grid = 0;
    if (grid == 0) {
        if (n_in != 15 || in_sizes[0] != M * D || out_size != M * D || ws_size < WS_END) { fprintf(stderr, "kernel_launch: unexpected shapes (n_in %d, in0 %d, out %d, ws %zu)\n", n_in, n_in > 0 ? in_sizes[0] : -1, out_size, ws_size); grid = -1; return; }
        int dev = 0, cus = 0, per_cu = 0;
        hipGetDevice(&dev);
        hipDeviceGetAttribute(&cus, hipDeviceAttributeMultiprocessorCount, dev);
        if (hipFuncSetAttribute((const void*)fwd_mega, hipFuncAttributeMaxDynamicSharedMemorySize, LDS_BYTES) != hipSuccess) { fprintf(stderr, "kernel_launch: hipFuncSetAttribute failed\n"); grid = -1; return; }
        if (hipOccupancyMaxActiveBlocksPerMultiprocessor(&per_cu, (const void*)fwd_mega, NTHREADS, LDS_BYTES) != hipSuccess || per_cu < 1) { fprintf(stderr, "kernel_launch: occupancy query says %d blocks per CU\n", per_cu); per_cu = 1; }
        (void)hipGetLastError();
        grid = cus * per_cu;
    }
    if (grid < 0) return;
    if (hipMemsetAsync(d_ws, 0, 16384, stream) != hipSuccess) { fprintf(stderr, "kernel_launch: hipMemsetAsync failed\n"); return; }
    Args a{};
    for (int i = 0; i < 15; ++i) a.in[i] = (const float*)d_in[i];
    a.out = (float*)d_out; a.ws = (unsigned char*)d_ws;
#if MK_LAUNCHES == 1
    a.ph_lo = 0; a.ph_hi = 5;
    void* args[] = {&a};
    hipError_t e = hipLaunchCooperativeKernel((const void*)fwd_mega, dim3(grid), dim3(NTHREADS), args, LDS_BYTES, stream);
    if (e != hipSuccess) fprintf(stderr, "kernel_launch: cooperative launch failed: %s (grid %d)\n", hipGetErrorString(e), grid);
#else
    for (int k = 0; k < 5; ++k) {
        a.ph_lo = k; a.ph_hi = k + 1;
        hipLaunchKernelGGL(fwd_mega, dim3(grid), dim3(NTHREADS), LDS_BYTES, stream, a);
    }
#endif
}
```

```cpp
#include <hip/hip_runtime.h>
#include <hip/hip_cooperative_groups.h>
#include <cstdio>
#include <cstdint>
namespace cg = cooperative_groups;
namespace pg8 {
#define PG8_LAS __attribute__((address_space(3)))
typedef unsigned short bf16_t;
typedef short bf16x8 __attribute__((ext_vector_type(8)));
typedef float f32x4 __attribute__((ext_vector_type(4)));
typedef unsigned u32x4 __attribute__((ext_vector_type(4)));
constexpr int BM = 256, BK = 64, HALF = 128, HTB = HALF * BK * 2  , STAGE_BYTES = 8 * HTB, NXCD = 8, WGM = 8;

__host__ __device__ __forceinline__ int lds_byte(int r, int c) { const int st = (r >> 4) * 2 + (c >> 5), rr = r & 15, cc = c & 31, ob = rr * 64 + cc * 2; return st * 1024 + (ob ^ (((ob >> 9) & 1) << 5)); }
__host__ __device__ __forceinline__ void stage_rc(int b, int& R, int& C) { const int st = b / 1024, sb = b % 1024, swz = sb ^ (((sb >> 9) & 1) << 5); R = (st >> 1) * 16 + swz / 64; C = (st & 1) * 32 + (swz % 64) / 2; }
__host__ __device__ __forceinline__ int perm32(int rho) { const int n = rho >> 4, i = rho & 15; return 8 * (i >> 2) + 4 * n + (i & 3); }

struct Unit { int pm, pn; };
struct Gemm { const bf16_t* A; const bf16_t* Bt; int M, N, K; };

struct StaticOrder {
    int nM, nN, nwg, G, c;
    __host__ __device__ void init(int M, int N, int G_, int c_) { nM = M / BM; nN = N / BM; nwg = nM * nN; G = G_; c = c_; }
    __host__ __device__ bool next(int i, Unit& u) const {
        const long L = (long)i * G + c; if (L >= nwg) return false;
        int wgid = (int)L; { const int q = nwg / NXCD, r = nwg % NXCD, xcd = wgid % NXCD, off = wgid / NXCD; wgid = (xcd < r ? xcd * (q + 1) : r * (q + 1) + (xcd - r) * q) + off; }
        const int nig = WGM * nN, gid = wgid / nig, fm = gid * WGM, gsz = (nM - fm) < WGM ? (nM - fm) : WGM;
        u.pm = fm + ((wgid % nig) % gsz); u.pn = (wgid % nig) / gsz; return true;
    }
    __device__ __forceinline__ void a_ready(const Unit&) const {}
    __device__ __forceinline__ void done(const Unit&) const {}
};

template <int REP> struct RepOrder : StaticOrder {
    __host__ __device__ bool next(int i, Unit& u) const {
        if constexpr (REP > 1) { const int per = (nwg - c + G - 1) / G; if (i >= per * REP) return false; i %= per; }
        return StaticOrder::next(i, u);
    }
};
__device__ __forceinline__ unsigned cvt_pk_bf16(float lo, float hi) { unsigned r; asm volatile("v_cvt_pk_bf16_f32 %0, %1, %2" : "=v"(r) : "v"(lo), "v"(hi)); return r; }

__device__ __forceinline__ float sigmoidf_(float v) { return __builtin_amdgcn_rcpf(1.0f + __expf(-v)); }
struct EpiIn {
    static constexpr bool PERM = true, AFTER_DRAIN = false;
    bf16_t* P; const float* bias; const float* rstd; size_t bufstride;
    __device__ __forceinline__ void operator()(const f32x4 (&acc)[2][2][4][2], const Unit& u, int wr, int wc, int fr, int fq) const {
        const int row0 = u.pm * BM + wr * 64 + fr;
        const int cb = u.pn * BM + wc * 32 + 8 * fq;
        f32x4 bv[2][2];
#pragma unroll
        for (int bj = 0; bj < 2; ++bj)
#pragma unroll
            for (int n = 0; n < 2; ++n) bv[bj][n] = *(const f32x4*)(bias + cb + bj * HALF + 4 * n);
        if (u.pn < 4) {
            bf16_t* base = P + (128 * u.pn + wc * 32 + 8 * fq);
#pragma unroll
            for (int ai = 0; ai < 2; ++ai)
#pragma unroll
                for (int m = 0; m < 4; ++m) {
                    const int row = row0 + ai * HALF + m * 16; const float rs = rstd[row];
                    f32x4 a0 = acc[ai][0][m][0] * rs + bv[0][0], a1 = acc[ai][0][m][1] * rs + bv[0][1];
                    f32x4 b0 = acc[ai][1][m][0] * rs + bv[1][0], b1 = acc[ai][1][m][1] * rs + bv[1][1];
#pragma unroll
                    for (int j = 0; j < 4; ++j) { a0[j] *= sigmoidf_(b0[j]); a1[j] *= sigmoidf_(b1[j]); }
                    u32x4 w; w.x = cvt_pk_bf16(a0[0], a0[1]); w.y = cvt_pk_bf16(a0[2], a0[3]); w.z = cvt_pk_bf16(a1[0], a1[1]); w.w = cvt_pk_bf16(a1[2], a1[3]);
                    *(u32x4*)(base + (size_t)row * 512) = w;
                }
        } else {
            const int t = (u.pn - 4) >> 1;
            bf16_t* base = P + (size_t)(t + 1) * bufstride + ((u.pn - 4) & 1) * 256 + wc * 32 + 8 * fq;
            const bool gate = (t == 0) || (t == 4); const float sc = (t == 1) ? 0.125f : 1.0f;
#pragma unroll
            for (int ai = 0; ai < 2; ++ai)
#pragma unroll
                for (int m = 0; m < 4; ++m) {
                    const int row = row0 + ai * HALF + m * 16; const float rs = rstd[row];
#pragma unroll
                    for (int bj = 0; bj < 2; ++bj) {
                        f32x4 v0 = acc[ai][bj][m][0] * rs + bv[bj][0], v1 = acc[ai][bj][m][1] * rs + bv[bj][1];
                        if (gate) {
#pragma unroll
                            for (int j = 0; j < 4; ++j) { v0[j] *= sigmoidf_(v0[j]); v1[j] *= sigmoidf_(v1[j]); }
                        }
                        v0 = v0 * sc; v1 = v1 * sc;
                        u32x4 w; w.x = cvt_pk_bf16(v0[0], v0[1]); w.y = cvt_pk_bf16(v0[2], v0[3]); w.z = cvt_pk_bf16(v1[0], v1[1]); w.w = cvt_pk_bf16(v1[2], v1[3]);
                        *(u32x4*)(base + (size_t)row * 512 + bj * HALF) = w;
                    }
                }
        }
    }
};
struct EpiOut {
    static constexpr bool PERM = true, AFTER_DRAIN = false;
    const float* x; float* out; float* sspart;
    __device__ __forceinline__ void operator()(const f32x4 (&acc)[2][2][4][2], const Unit& u, int wr, int wc, int fr, int fq) const {
        const int row0 = u.pm * BM + wr * 64 + fr;
        const int col0 = u.pn * BM + wc * 32 + 8 * fq;
#pragma unroll
        for (int ai = 0; ai < 2; ++ai)
#pragma unroll
            for (int m = 0; m < 4; ++m) {
                const int row = row0 + ai * HALF + m * 16; float ss = 0.f;
#pragma unroll
                for (int bj = 0; bj < 2; ++bj) {
                    const size_t off = (size_t)row * 1024 + col0 + bj * HALF;
                    const f32x4 x0 = *(const f32x4*)(x + off), x1 = *(const f32x4*)(x + off + 4);
                    const f32x4 h0 = x0 + acc[ai][bj][m][0], h1 = x1 + acc[ai][bj][m][1];
                    *(f32x4*)(out + off) = h0; *(f32x4*)(out + off + 4) = h1;
                    ss += (h0[0] * h0[0] + h0[1] * h0[1]) + (h0[2] * h0[2] + h0[3] * h0[3]) + (h1[0] * h1[0] + h1[1] * h1[1]) + (h1[2] * h1[2] + h1[3] * h1[3]);
                }
                ss += __shfl_xor(ss, 16); ss += __shfl_xor(ss, 32);
                if (fq == 0) sspart[(size_t)row * 16 + u.pn * 4 + wc] = ss;
            }
    }
};

template <class Epi, class Sched, bool ALIGN_EPI = false, bool SP2 = false>
__device__ __forceinline__ void gemm_phase(PG8_LAS unsigned char* lds, const Gemm g, const Sched& S, const Epi& E) {
    const int tid = threadIdx.x, wid = __builtin_amdgcn_readfirstlane(tid >> 6), lane = tid & 63, wr = wid >> 2, wc = wid & 3, fr = lane & 15, fq = lane >> 4;
    const int K = g.K, nt = K / BK;
    unsigned voffA[2], voffB[2];
#pragma unroll
    for (int i = 0; i < 2; ++i) { int R, C; stage_rc(tid * 16 + i * 8192, R, C); const int Rb = Epi::PERM ? ((R & ~31) + perm32(R & 31)) : R;
        voffA[i] = (unsigned)(R * K + C) * 2u; voffB[i] = (unsigned)(Rb * K + C) * 2u; }
    const size_t kstep = (size_t)(BK * 2);
    const size_t hstep = (size_t)HALF * K * 2;
    const size_t tstep = 2 * hstep;
    const unsigned ldsw = (unsigned)wid * 1024u;
    const int aoff = lds_byte(wr * 64 + fr, fq * 8), boff = lds_byte(wc * 32 + fr, fq * 8);
#define PG8_SA(b, h) (((b) * 2 + (h)) * HTB)
#define PG8_SB(b, h) ((4 + (b) * 2 + (h)) * HTB)
#define PG8_STAGE(bufoff, gbase, voff) do { _Pragma("unroll") for (int _i = 0; _i < 2; ++_i) \
        __builtin_amdgcn_global_load_lds((const unsigned*)((const char*)(gbase) + (voff)[_i]), (PG8_LAS unsigned*)(lds + (bufoff) + ldsw + _i * 8192), 16, 0, 0); } while (0)
#define PG8_LDA(dst, b, h) do { _Pragma("unroll") for (int m = 0; m < 4; ++m) _Pragma("unroll") for (int k = 0; k < 2; ++k) dst[m][k] = *(const PG8_LAS bf16x8*)(lds + PG8_SA(b, h) + aoff + m * 2048 + k * 1024); } while (0)
#define PG8_LDB(dst, b, h) do { _Pragma("unroll") for (int n = 0; n < 2; ++n) _Pragma("unroll") for (int k = 0; k < 2; ++k) dst[n][k] = *(const PG8_LAS bf16x8*)(lds + PG8_SB(b, h) + boff + n * 2048 + k * 1024); } while (0)
#define PG8_MMA(ai, bj, At, Bt) do { __builtin_amdgcn_s_setprio(1); _Pragma("unroll") for (int m = 0; m < 4; ++m) _Pragma("unroll") for (int n = 0; n < 2; ++n) _Pragma("unroll") for (int k = 0; k < 2; ++k) \
        acc[ai][bj][m][n] = __builtin_amdgcn_mfma_f32_16x16x32_bf16(Bt[n][k], At[m][k], acc[ai][bj][m][n], 0, 0, 0); __builtin_amdgcn_s_setprio(0); } while (0)
#define PG8_WAIT_V(n) asm volatile("s_waitcnt vmcnt(" #n ")" ::: "memory")
#define PG8_WAIT_L(n) asm volatile("s_waitcnt lgkmcnt(" #n ")" ::: "memory")
#define PG8_BAR __builtin_amdgcn_s_barrier()
#define PG8_SCHED __builtin_amdgcn_sched_barrier(0)
    Unit cur, nxt; int ui = 0;
    if (!S.next(0, cur)) return;
    f32x4 acc[2][2][4][2];
#pragma unroll
    for (int a = 0; a < 2; ++a)
#pragma unroll
        for (int b = 0; b < 2; ++b)
#pragma unroll
            for (int m = 0; m < 4; ++m)
#pragma unroll
                for (int n = 0; n < 2; ++n) acc[a][b][m][n] = (f32x4){0.f, 0.f, 0.f, 0.f};
    bf16x8 At[4][2], B0[2][2], B1[2][2];
    const char* cA = (const char*)g.A + (size_t)cur.pm * tstep; const char* cB = (const char*)g.Bt + (size_t)cur.pn * tstep;
    S.a_ready(cur);
    if constexpr (SP2) {
        PG8_STAGE(PG8_SB(0, 0), cB, voffB); PG8_STAGE(PG8_SB(0, 1), cB + hstep, voffB); PG8_STAGE(PG8_SA(0, 0), cA, voffA); PG8_STAGE(PG8_SA(0, 1), cA + hstep, voffA);
        if (wr == 1) PG8_BAR;
        PG8_WAIT_V(2); PG8_BAR;
        PG8_STAGE(PG8_SB(1, 0), cB + kstep, voffB); PG8_STAGE(PG8_SA(1, 0), cA + kstep, voffA); PG8_STAGE(PG8_SB(1, 1), cB + hstep + kstep, voffB);
        PG8_WAIT_V(6); PG8_BAR;
    } else {
        PG8_STAGE(PG8_SB(0, 0), cB, voffB); PG8_STAGE(PG8_SA(0, 0), cA, voffA); PG8_STAGE(PG8_SB(0, 1), cB + hstep, voffB); PG8_STAGE(PG8_SA(0, 1), cA + hstep, voffA);
        if (wr == 1) PG8_BAR;
        PG8_WAIT_V(4); PG8_BAR;
        PG8_STAGE(PG8_SB(1, 0), cB + kstep, voffB); PG8_STAGE(PG8_SA(1, 0), cA + kstep, voffA); PG8_STAGE(PG8_SB(1, 1), cB + hstep + kstep, voffB);
        PG8_WAIT_V(6); PG8_BAR;
    }
    for (;;) {
        const bool has_next = S.next(ui + 1, nxt);
        const char* nA = has_next ? (const char*)g.A + (size_t)nxt.pm * tstep : cA; const char* nB = has_next ? (const char*)g.Bt + (size_t)nxt.pn * tstep : cB;
        for (int t = 0; t < nt; t += 2) {
            const bool last = (t == nt - 2);
            const char* a1 = cA + (size_t)(t + 1) * kstep;
            const char* a2 = last ? nA : cA + (size_t)(t + 2) * kstep; const char* b2 = last ? nB : cB + (size_t)(t + 2) * kstep;
            const char* a3 = a2 + kstep; const char* b3 = b2 + kstep;
            if (last && has_next) S.a_ready(nxt);
            if constexpr (SP2) {
            PG8_LDB(B0, 0, 0); PG8_LDB(B1, 0, 1); PG8_SCHED; PG8_LDA(At, 0, 0); PG8_STAGE(PG8_SA(1, 1), a1 + hstep, voffA);
            PG8_WAIT_V(8); PG8_WAIT_L(0); PG8_BAR; PG8_MMA(0, 0, At, B0); PG8_MMA(0, 1, At, B1); PG8_BAR; PG8_SCHED;
            PG8_LDA(At, 0, 1); PG8_STAGE(PG8_SB(0, 0), b2, voffB); PG8_STAGE(PG8_SB(0, 1), b2 + hstep, voffB); PG8_STAGE(PG8_SA(0, 0), a2, voffA);
            PG8_WAIT_V(8); PG8_WAIT_L(0); PG8_BAR; PG8_MMA(1, 0, At, B0); PG8_MMA(1, 1, At, B1); PG8_BAR; PG8_SCHED;
            PG8_LDB(B0, 1, 0); PG8_LDB(B1, 1, 1); PG8_SCHED; PG8_LDA(At, 1, 0); PG8_STAGE(PG8_SA(0, 1), a2 + hstep, voffA);
            PG8_WAIT_V(8); PG8_WAIT_L(0); PG8_BAR; PG8_MMA(0, 0, At, B0); PG8_MMA(0, 1, At, B1); PG8_BAR; PG8_SCHED;
            PG8_LDA(At, 1, 1); PG8_STAGE(PG8_SB(1, 0), b3, voffB); PG8_STAGE(PG8_SB(1, 1), b3 + hstep, voffB); PG8_STAGE(PG8_SA(1, 0), a3, voffA);
            PG8_WAIT_V(8); PG8_WAIT_L(0); PG8_BAR; PG8_MMA(1, 0, At, B0); PG8_MMA(1, 1, At, B1); PG8_BAR; PG8_SCHED;
            } else {
            PG8_LDB(B0, 0, 0); PG8_SCHED; PG8_LDA(At, 0, 0); PG8_STAGE(PG8_SA(1, 1), a1 + hstep, voffA);
            PG8_WAIT_L(8); PG8_BAR; PG8_WAIT_L(0); PG8_MMA(0, 0, At, B0); PG8_BAR; PG8_SCHED;
            PG8_LDB(B1, 0, 1); PG8_STAGE(PG8_SB(0, 0), b2, voffB);
            PG8_BAR; PG8_WAIT_L(0); PG8_MMA(0, 1, At, B1); PG8_BAR;
            PG8_LDA(At, 0, 1); PG8_STAGE(PG8_SA(0, 0), a2, voffA);
            PG8_BAR; PG8_WAIT_L(0); PG8_MMA(1, 0, At, B0); PG8_BAR; PG8_SCHED;
            PG8_STAGE(PG8_SB(0, 1), b2 + hstep, voffB);
            PG8_WAIT_V(6); PG8_BAR; PG8_MMA(1, 1, At, B1); PG8_BAR;
            PG8_LDB(B0, 1, 0); PG8_SCHED; PG8_LDA(At, 1, 0); PG8_STAGE(PG8_SA(0, 1), a2 + hstep, voffA);
            PG8_WAIT_L(8); PG8_BAR; PG8_WAIT_L(0); PG8_MMA(0, 0, At, B0); PG8_BAR; PG8_SCHED;
            PG8_LDB(B1, 1, 1); PG8_STAGE(PG8_SB(1, 0), b3, voffB);
            PG8_BAR; PG8_WAIT_L(0); PG8_MMA(0, 1, At, B1); PG8_BAR;
            PG8_LDA(At, 1, 1); PG8_STAGE(PG8_SA(1, 0), a3, voffA);
            PG8_BAR; PG8_WAIT_L(0); PG8_MMA(1, 0, At, B0); PG8_BAR; PG8_SCHED;
            PG8_STAGE(PG8_SB(1, 1), b3 + hstep, voffB);
            PG8_WAIT_V(6); PG8_BAR; PG8_MMA(1, 1, At, B1); PG8_BAR;
            }
        }
        if constexpr (ALIGN_EPI) { if (wr == 0) PG8_BAR; }
        if constexpr (!Epi::AFTER_DRAIN) { E(acc, cur, wr, wc, fr, fq); S.done(cur); }
        if (!has_next) break;
#pragma unroll
        for (int a = 0; a < 2; ++a)
#pragma unroll
            for (int b = 0; b < 2; ++b)
#pragma unroll
                for (int m = 0; m < 4; ++m)
#pragma unroll
                    for (int n = 0; n < 2; ++n) acc[a][b][m][n] = (f32x4){0.f, 0.f, 0.f, 0.f};
        cur = nxt; cA = nA; cB = nB; ++ui;
        if constexpr (ALIGN_EPI) { if (wr == 1) PG8_BAR; }
    }
    PG8_WAIT_V(0);
    if constexpr (!ALIGN_EPI) { if (wr == 0) PG8_BAR; }
    PG8_BAR;
    if constexpr (Epi::AFTER_DRAIN) { E.fused(acc, cur, wr, wc, fr, fq, lds, wid, lane); S.done(cur); }
#undef PG8_SA
#undef PG8_SB
#undef PG8_STAGE
#undef PG8_LDA
#undef PG8_LDB
#undef PG8_MMA
#undef PG8_WAIT_V
#undef PG8_WAIT_L
#undef PG8_BAR
#undef PG8_SCHED
}
}

#ifndef MK_LAUNCHES
#define MK_LAUNCHES 1
#endif
#ifndef REP_P0
#define REP_P0 1
#endif
#ifndef REP_P1
#define REP_P1 1
#endif
#ifndef REP_P3
#define REP_P3 1
#endif
typedef unsigned short bf16;
typedef short bf16x8 __attribute__((ext_vector_type(8)));
typedef short s16x4 __attribute__((ext_vector_type(4)));
typedef float f32x4 __attribute__((ext_vector_type(4)));
typedef float f32x16 __attribute__((ext_vector_type(16)));
typedef unsigned u32x4 __attribute__((ext_vector_type(4)));
typedef unsigned u32x2 __attribute__((ext_vector_type(2)));
#define LASX __attribute__((address_space(3)))

constexpr int BATCH = 2, SEQ = 8192, D = 1024, M = BATCH * SEQ, NPROJ = 3584;
constexpr float EPS = 1e-6f;
constexpr size_t MiB = 1u << 20;
constexpr size_t WS_WIN = 1 * MiB, WS_WOUT = 9 * MiB, WS_PW = 11 * MiB, WS_BIAS = 12 * MiB, WS_RSTD = 12 * MiB + 65536, WS_SSP = 13 * MiB;
constexpr size_t WS_XB = 16 * MiB, WS_P = 48 * MiB, WS_Y = 144 * MiB, WS_END = 176 * MiB;
constexpr size_t PBUF = (size_t)M * 512;
constexpr int LDS_BYTES = 147456;
constexpr int NTHREADS = 512, NWAVES = 8;

__device__ __forceinline__ float bf_lo(unsigned u) { return __builtin_bit_cast(float, u << 16); }
__device__ __forceinline__ float bf_hi(unsigned u) { return __builtin_bit_cast(float, u & 0xffff0000u); }
__device__ __forceinline__ unsigned pkbf(float lo, float hi) { unsigned r; asm("v_cvt_pk_bf16_f32 %0, %1, %2" : "=v"(r) : "v"(lo), "v"(hi)); return r; }
__device__ __forceinline__ float wave_sum(float v) {
#pragma unroll
    for (int o = 1; o < 64; o <<= 1) v += __shfl_xor(v, o);
    return v;
}
#define LDS_WAIT() asm volatile("s_waitcnt lgkmcnt(0)" ::: "memory")

__device__ __forceinline__ int colmap(int n) {
    if (n >= 1024) return n;
    if (n < 512) return 256 * (n >> 7) + (n & 127);
    n -= 512; return 256 * (n >> 7) + 128 + (n & 127);
}
__device__ __forceinline__ void transpose_item(const float* __restrict__ W, const float* __restrict__ g, int K, int N, bf16* WT, int mode, float* scr, int item, int lane) {
    const int nblk = N / 32, kb = item / nblk, nb = item % nblk, k0 = 64 * kb, n0 = 32 * nb;
#pragma unroll 8
    for (int i = 0; i < 32; ++i) { const int kk = 2 * i + (lane >> 5); float v = W[(size_t)(k0 + kk) * N + n0 + (lane & 31)]; if (g) v *= g[k0 + kk]; scr[kk * 33 + (lane & 31)] = v; }
    LDS_WAIT();
    const int c = lane & 7; const int row_off = (mode == 1) ? colmap(n0) : n0;
#pragma unroll
    for (int j = 0; j < 4; ++j) { const int n = (lane >> 3) + 8 * j; const float* s = scr + (8 * c) * 33 + n;
        u32x4 o; o.x = pkbf(s[0 * 33], s[1 * 33]); o.y = pkbf(s[2 * 33], s[3 * 33]); o.z = pkbf(s[4 * 33], s[5 * 33]); o.w = pkbf(s[6 * 33], s[7 * 33]);
        if (mode == 2) {
            const int k8 = (k0 >> 3) + c, T = nb, ks = k8 >> 1, ln = n + 32 * (k8 & 1);
            *(u32x4*)(WT + ((size_t)(T * (K >> 4) + ks) * 64 + ln) * 8) = o;
        } else *(u32x4*)(WT + (size_t)(row_off + n) * K + k0 + 8 * c) = o; }
    LDS_WAIT();
}

struct Args { const float* in[15]; float* out; unsigned char* ws; int ph_lo, ph_hi; int pad0, pad1; };

__device__ __forceinline__ void p0_prologue(unsigned char* lds, const Args& a, int G) {
    const int tid = threadIdx.x, lane = tid & 63, wave = tid >> 6;
    const float* x = a.in[0]; const float* ln_g = a.in[1]; const float* w_in = a.in[2]; const float* b_in = a.in[3];
    const float* pw_w = a.in[8]; const float* w_out = a.in[13];
    bf16* Wt_in = (bf16*)(a.ws + WS_WIN); bf16* Wt_out = (bf16*)(a.ws + WS_WOUT); bf16* Wt_pw = (bf16*)(a.ws + WS_PW);
    float* biasp = (float*)(a.ws + WS_BIAS); float* rstd = (float*)(a.ws + WS_RSTD); bf16* XB = (bf16*)(a.ws + WS_XB);
    float* scr = (float*)(lds + wave * 16384);
    const int gw = blockIdx.x * NWAVES + wave, NGW = G * NWAVES;
    constexpr int I_IN = (D / 64) * (NPROJ / 32), I_OUT = (D / 64) * (D / 32), I_PW = (512 / 64) * (512 / 32);
    for (int it = gw; it < I_IN + I_OUT + I_PW; it += NGW) {
        int r = it;
        if (r < I_IN) { transpose_item(w_in, ln_g, D, NPROJ, Wt_in, 1, scr, r, lane); continue; } r -= I_IN;
        if (r < I_OUT) { transpose_item(w_out, nullptr, D, D, Wt_out, 0, scr, r, lane); continue; } r -= I_OUT;
        transpose_item(pw_w, nullptr, 512, 512, Wt_pw, 2, scr, r, lane);
    }
    for (int n = blockIdx.x * NTHREADS + tid; n < NPROJ; n += G * NTHREADS) biasp[colmap(n)] = b_in[n];
    for (int m = gw; m < M; m += NGW) {
        const f32x4* xr = (const f32x4*)(x + (size_t)m * D) + lane;
        f32x4 v[4]; float s = 0.f;
#pragma unroll
        for (int j = 0; j < 4; ++j) { v[j] = xr[64 * j]; s += (v[j].x * v[j].x + v[j].y * v[j].y) + (v[j].z * v[j].z + v[j].w * v[j].w); }
        s = wave_sum(s);
        if (lane == 0) rstd[m] = 1.0f / sqrtf(s * (1.0f / D) + EPS);
        u32x2* o8 = (u32x2*)(XB + (size_t)m * D) + lane;
#pragma unroll
        for (int j = 0; j < 4; ++j) { u32x2 o; o.x = pkbf(v[j].x, v[j].y); o.y = pkbf(v[j].z, v[j].w); o8[64 * j] = o; }
    }
}

constexpr int CV_W_PITCH = 144, CV_W_BYTES = 512 * CV_W_PITCH;
constexpr int CV_VN_OFF = CV_W_BYTES, CV_VN_PITCH = 1040;
static_assert(CV_VN_OFF + 32 * CV_VN_PITCH <= LDS_BYTES && 62 * 1024 <= CV_W_BYTES, "conv LDS map");

__device__ __forceinline__ void conv_unit(unsigned char* lds, int unit, const bf16* __restrict__ U, const bf16* __restrict__ ZC, const float* __restrict__ dw_w, const float* __restrict__ dw_b,
                                          const float* __restrict__ cln_g, const float* __restrict__ cln_b, const bf16* __restrict__ pw_t, const float* __restrict__ pw_b,
                                          const float* __restrict__ gn_g, bf16* __restrict__ Y) {
    const int tid = threadIdx.x, lane = tid & 63, w = tid >> 6;
    const int b = unit >> 8, tok0 = (unit & 255) * 32;
    const size_t rowbase = (size_t)b * SEQ;
    {
        u32x4 hv[8];
#pragma unroll
        for (int i = 0; i < 8; ++i) {
            const int idx = tid + i * NTHREADS, row = idx >> 6, ch = idx & 63, t = tok0 - 15 + row;
            const int tc = min(max(t, 0), SEQ - 1);
            hv[i] = *(const u32x4*)(U + (rowbase + tc) * 512 + ch * 8);
            if (t < 0 || t >= SEQ) hv[i] = (u32x4){0u, 0u, 0u, 0u};
        }
#pragma unroll
        for (int i = 0; i < 8; ++i) { const int idx = tid + i * NTHREADS, row = idx >> 6, ch = idx & 63; if (row < 62) *(u32x4*)(lds + row * 1024 + ch * 16) = hv[i]; }
    }
    const int cp = tid & 255, th = tid >> 8;
    float w0[31], w1[31];
#pragma unroll
    for (int j = 0; j < 31; ++j) { const float2 ww = *(const float2*)(dw_w + j * 512 + 2 * cp); w0[j] = ww.x; w1[j] = ww.y; }
    float a0[16], a1[16];
    { const float2 bb = *(const float2*)(dw_b + 2 * cp);
#pragma unroll
      for (int o = 0; o < 16; ++o) { a0[o] = bb.x; a1[o] = bb.y; } }
    __syncthreads();
#pragma unroll
    for (int i = 0; i < 46; ++i) {
        const unsigned uu = *(const unsigned*)(lds + (16 * th + i) * 1024 + cp * 4);
        const float u0 = bf_lo(uu), u1 = bf_hi(uu);
#pragma unroll
        for (int j = 0; j < 31; ++j) { const int o = i - j; if (o >= 0 && o < 16) { a0[o] = fmaf(w0[j], u0, a0[o]); a1[o] = fmaf(w1[j], u1, a1[o]); } }
        if ((i & 7) == 7) __builtin_amdgcn_sched_barrier(0);
    }
#pragma unroll
    for (int o = 0; o < 16; ++o) *(unsigned*)(lds + CV_VN_OFF + (16 * th + o) * CV_VN_PITCH + cp * 4) = pkbf(a0[o], a1[o]);
    __syncthreads();
    {
        const f32x4 g0 = *(const f32x4*)(cln_g + 8 * lane), g1 = *(const f32x4*)(cln_g + 8 * lane + 4);
        const f32x4 c0 = *(const f32x4*)(cln_b + 8 * lane), c1 = *(const f32x4*)(cln_b + 8 * lane + 4);
#pragma unroll
        for (int tt = 0; tt < 4; ++tt) {
            unsigned char* p = lds + CV_VN_OFF + (4 * w + tt) * CV_VN_PITCH + lane * 16;
            const u32x4 raw = *(const u32x4*)p;
            float v[8] = {bf_lo(raw.x), bf_hi(raw.x), bf_lo(raw.y), bf_hi(raw.y), bf_lo(raw.z), bf_hi(raw.z), bf_lo(raw.w), bf_hi(raw.w)};
            float s = 0.f;
#pragma unroll
            for (int e = 0; e < 8; ++e) s += v[e];
            const float mean = wave_sum(s) * (1.0f / 512.0f);
            float q = 0.f;
#pragma unroll
            for (int e = 0; e < 8; ++e) { v[e] -= mean; q += v[e] * v[e]; }
            const float rstd = 1.0f / sqrtf(wave_sum(q) * (1.0f / 512.0f) + EPS);
            const float gg[8] = {g0[0], g0[1], g0[2], g0[3], g1[0], g1[1], g1[2], g1[3]};
            const float cc[8] = {c0[0], c0[1], c0[2], c0[3], c1[0], c1[1], c1[2], c1[3]};
#pragma unroll
            for (int e = 0; e < 8; ++e) { const float n = v[e] * rstd * gg[e] + cc[e]; v[e] = n * pg8::sigmoidf_(n); }
            u32x4 o; o.x = pkbf(v[0], v[1]); o.y = pkbf(v[2], v[3]); o.z = pkbf(v[4], v[5]); o.w = pkbf(v[6], v[7]);
            *(u32x4*)p = o;
        }
    }
    __syncthreads();
    const int r32 = lane & 31, h2 = lane >> 5;
    f32x16 acc[2];
#pragma unroll
    for (int a = 0; a < 2; ++a)
#pragma unroll
        for (int e = 0; e < 16; ++e) acc[a][e] = 0.f;
    {
        const unsigned char* wp0 = (const unsigned char*)pw_t + (size_t)(2 * w) * 32768 + lane * 16;
        const unsigned char* wp1 = wp0 + 32768;
        const unsigned char* bp = lds + CV_VN_OFF + r32 * CV_VN_PITCH + 16 * h2;
        u32x4 wA[8], wB[8];
#define CV_LD(dst, off) do { _Pragma("unroll") for (int ss = 0; ss < 4; ++ss) { dst[2 * ss] = *(const u32x4*)(wp0 + (off) + ss * 1024); dst[2 * ss + 1] = *(const u32x4*)(wp1 + (off) + ss * 1024); } } while (0)
#define CV_MM(src, off) do { _Pragma("unroll") for (int ss = 0; ss < 4; ++ss) { const bf16x8 bfr = *(const bf16x8*)(bp + (off) + ss * 32); \
            acc[0] = __builtin_amdgcn_mfma_f32_32x32x16_bf16(__builtin_bit_cast(bf16x8, src[2 * ss]), bfr, acc[0], 0, 0, 0); \
            acc[1] = __builtin_amdgcn_mfma_f32_32x32x16_bf16(__builtin_bit_cast(bf16x8, src[2 * ss + 1]), bfr, acc[1], 0, 0, 0); } } while (0)
        CV_LD(wA, 0);
#pragma unroll 1
        for (int g2 = 0; g2 < 4; ++g2) {
            CV_LD(wB, 4096);
            CV_MM(wA, 0);
            wp0 += 8192; wp1 += 8192;
            if (g2 < 3) CV_LD(wA, 0);
            CV_MM(wB, 128);
            bp += 256;
        }
#undef CV_LD
#undef CV_MM
    }
    const size_t row = rowbase + tok0 + r32;
    float ss = 0.f;
#pragma unroll
    for (int a = 0; a < 2; ++a)
#pragma unroll
        for (int rg = 0; rg < 4; ++rg) {
            const f32x4 pb = *(const f32x4*)(pw_b + 64 * w + 32 * a + 8 * rg + 4 * h2);
#pragma unroll
            for (int j = 0; j < 4; ++j) { const float v = acc[a][4 * rg + j] + pb[j]; acc[a][4 * rg + j] = v; ss += v * v; }
        }
    ss += __shfl_xor(ss, 32);
    const float rstd = 1.0f / sqrtf(ss * (1.0f / 64.0f) + EPS);
#pragma unroll
    for (int a = 0; a < 2; ++a)
#pragma unroll
        for (int rg = 0; rg < 4; ++rg) {
            const int oc0 = 64 * w + 32 * a + 8 * rg + 4 * h2;
            const f32x4 g = *(const f32x4*)(gn_g + oc0);
            const u32x2 z = *(const u32x2*)(ZC + row * 512 + oc0);
            u32x2 o;
            o.x = pkbf(acc[a][4 * rg + 0] * rstd * g[0] * bf_lo(z.x), acc[a][4 * rg + 1] * rstd * g[1] * bf_hi(z.x));
            o.y = pkbf(acc[a][4 * rg + 2] * rstd * g[2] * bf_lo(z.y), acc[a][4 * rg + 3] * rstd * g[3] * bf_hi(z.y));
            *(u32x2*)(Y + row * 1024 + oc0) = o;
        }
    __syncthreads();
}

constexpr int AT_RPB_OFF = 2 * 8 * 64 * 128;
static_assert(AT_RPB_OFF + 2 * 465 * 4 <= LDS_BYTES - 16, "attention LDS map");
__device__ __forceinline__ s16x4 vtr(const unsigned char* p) {
    typedef short v4i16_t __attribute__((ext_vector_type(4)));
    return __builtin_bit_cast(s16x4, __builtin_amdgcn_ds_read_tr16_b64_v4i16((LASX v4i16_t*)p));
}
__device__ __forceinline__ void attn_unit(unsigned char* lds, int unit, const bf16* __restrict__ Q, const bf16* __restrict__ K, const bf16* __restrict__ V, const bf16* __restrict__ ZA,
                                          const float* __restrict__ rpb, const float* __restrict__ gn_g, bf16* __restrict__ Y) {
    const int tid = threadIdx.x, lane = tid & 63, w = tid >> 6;
    const int b = unit >> 9, hp = (unit >> 7) & 3, r = unit & 127;
    const int rs = min(max(r - 4, 0), 120);
    const size_t rowbase = (size_t)b * SEQ;
#pragma unroll
    for (int hb = 0; hb < 2; ++hb) {
        u32x4 vv[8];
#pragma unroll
        for (int k = 0; k < 8; ++k) {
            const int idx = tid + (hb * 8 + k) * NTHREADS, tr = idx >> 4, c16 = idx & 15, i = tr >> 6, tok = tr & 63;
            vv[k] = *(const u32x4*)(V + (rowbase + (size_t)(rs + i) * 64 + tok) * 512 + hp * 128 + c16 * 8);
        }
#pragma unroll
        for (int k = 0; k < 8; ++k) {
            const int idx = tid + (hb * 8 + k) * NTHREADS, tr = idx >> 4, c16 = idx & 15, tok = tr & 63, head = c16 >> 3, ch = c16 & 7;
            *(u32x4*)(lds + head * 65536 + tr * 128 + (((ch >> 1) ^ ((tok >> 1) & 3)) << 5) + ((ch & 1) << 4)) = vv[k];
        }
    }
    for (int idx = tid; idx < 930; idx += NTHREADS) ((float*)(lds + AT_RPB_OFF))[idx] = rpb[hp * 930 + idx];
    __syncthreads();
    const int hl = w >> 2, c = w & 3, h = 2 * hp + hl;
    const int wc0 = (c == 0) ? 0 : (c == 1) ? 8 : (c == 2) ? 24 : 32;
    const int l16 = lane & 15, g = lane >> 4;
    const size_t tq = rowbase + (size_t)r * 64 + 16 * c + l16;
    const bf16x8 qf0 = *(const bf16x8*)(Q + tq * 512 + h * 64 + 8 * g), qf1 = *(const bf16x8*)(Q + tq * 512 + h * 64 + 32 + 8 * g);
    f32x4 st[8][2];
#pragma unroll
    for (int i = 0; i < 8; ++i)
#pragma unroll
        for (int hh = 0; hh < 2; ++hh) {
            const bf16* kp = K + (rowbase + (size_t)(rs + i) * 64 + wc0 + 16 * hh + l16) * 512 + h * 64 + 8 * g;
            const bf16x8 k0 = *(const bf16x8*)kp, k1 = *(const bf16x8*)(kp + 32);
            f32x4 z = {0.f, 0.f, 0.f, 0.f};
            z = __builtin_amdgcn_mfma_f32_16x16x32_bf16(k0, qf0, z, 0, 0, 0);
            z = __builtin_amdgcn_mfma_f32_16x16x32_bf16(k1, qf1, z, 0, 0, 0);
            st[i][hh] = z;
        }
    const int wq = 16 * c + l16, cs = min(max(wq - 8, 0), 48);
    const float* tbl = (const float*)(lds + AT_RPB_OFF) + hl * 465;
    float mx = -1e30f;
#pragma unroll
    for (int i = 0; i < 8; ++i) {
        const int rowoff = (rs + i - r + 7) * 31 - wq + 15;
#pragma unroll
        for (int hh = 0; hh < 2; ++hh)
#pragma unroll
            for (int j = 0; j < 4; ++j) {
                const int kc = wc0 + 16 * hh + 4 * g + j;
                const bool inw = (kc >= cs) && (kc < cs + 16);
                const float bias = tbl[inw ? rowoff + kc : 0];
                const float s = inw ? st[i][hh][j] + bias : -1e30f;
                st[i][hh][j] = s; mx = fmaxf(mx, s);
            }
    }
    mx = fmaxf(mx, __shfl_xor(mx, 16)); mx = fmaxf(mx, __shfl_xor(mx, 32));
    float sum = 0.f;
#pragma unroll
    for (int i = 0; i < 8; ++i)
#pragma unroll
        for (int hh = 0; hh < 2; ++hh)
#pragma unroll
            for (int j = 0; j < 4; ++j) { const float p = __builtin_amdgcn_exp2f((st[i][hh][j] - mx) * 1.4426950408889634f); st[i][hh][j] = p; sum += p; }
    sum += __shfl_xor(sum, 16); sum += __shfl_xor(sum, 32);
    const unsigned char* vb = lds + hl * 65536;
    const int qq = l16 >> 2, pp = l16 & 3;
    const int key0 = wc0 + 4 * g + qq, sw = (key0 >> 1) & 3;
    f32x4 o[4];
#pragma unroll
    for (int ht = 0; ht < 4; ++ht) o[ht] = (f32x4){0.f, 0.f, 0.f, 0.f};
#pragma unroll
    for (int i = 0; i < 8; ++i) {
        u32x4 pw; pw.x = pkbf(st[i][0][0], st[i][0][1]); pw.y = pkbf(st[i][0][2], st[i][0][3]); pw.z = pkbf(st[i][1][0], st[i][1][1]); pw.w = pkbf(st[i][1][2], st[i][1][3]);
        const bf16x8 pf = __builtin_bit_cast(bf16x8, pw);
#pragma unroll
        for (int ht = 0; ht < 4; ++ht) {
            const unsigned char* a0 = vb + (i * 64 + key0) * 128 + ((ht ^ sw) << 5) + 8 * pp;
            const s16x4 lo = vtr(a0), hi = vtr(a0 + 16 * 128);
            const bf16x8 vf = __builtin_shufflevector(lo, hi, 0, 1, 2, 3, 4, 5, 6, 7);
            o[ht] = __builtin_amdgcn_mfma_f32_16x16x32_bf16(vf, pf, o[ht], 0, 0, 0);
        }
    }
    const float inv = 1.0f / sum;
    float ss = 0.f;
#pragma unroll
    for (int ht = 0; ht < 4; ++ht)
#pragma unroll
        for (int j = 0; j < 4; ++j) { const float v = o[ht][j] * inv; o[ht][j] = v; ss += v * v; }
    ss += __shfl_xor(ss, 16); ss += __shfl_xor(ss, 32);
    const float rstd = 1.0f / sqrtf(ss * (1.0f / 64.0f) + EPS);
#pragma unroll
    for (int ht = 0; ht < 4; ++ht) {
        const int ch = h * 64 + 16 * ht + 4 * g;
        const f32x4 gg = *(const f32x4*)(gn_g + ch);
        const u32x2 z = *(const u32x2*)(ZA + tq * 512 + ch);
        u32x2 ov;
        ov.x = pkbf(o[ht][0] * rstd * gg[0] * bf_lo(z.x), o[ht][1] * rstd * gg[1] * bf_hi(z.x));
        ov.y = pkbf(o[ht][2] * rstd * gg[2] * bf_lo(z.y), o[ht][3] * rstd * gg[3] * bf_hi(z.y));
        *(u32x2*)(Y + tq * 1024 + 512 + ch) = ov;
    }
    __syncthreads();
}

#define LAS __attribute__((address_space(3)))
#define XB_TMO      128
#define XB_XCNT(j)  (256  + 64 * (j))
#define XB_XSUB(j)  (1280 + 64 * (j))
#define XB_XGEN(j)  (2304 + 64 * (j))
#define XB_TOP      3328
#define XB_TOPGEN   3392
#define XCD_BAR_WORDS 3456
#define XB_SPIN_CAP (1u << 18)

__device__ __forceinline__ unsigned xb_ld(unsigned* p)              { return __hip_atomic_load(p, __ATOMIC_RELAXED, __HIP_MEMORY_SCOPE_AGENT); }
__device__ __forceinline__ unsigned xb_add(unsigned* p, unsigned v) { return __hip_atomic_fetch_add(p, v, __ATOMIC_RELAXED, __HIP_MEMORY_SCOPE_AGENT); }
__device__ __forceinline__ unsigned xb_xcc_id() { return (unsigned)__builtin_amdgcn_s_getreg((3 << 11) | 20) & 0xFu; }
#define XB_SPIN(cond, bar) do { unsigned _sp = 0; while (cond) { __builtin_amdgcn_s_sleep(1); \
    if ((++_sp & 255u) == 0u) { if (xb_ld(&(bar)[XB_TMO])) break; if (_sp > XB_SPIN_CAP) { atomicAdd(&(bar)[XB_TMO], 1u); break; } } } } while (0)

struct XcdBarrier {
    unsigned* bar; unsigned x;
    volatile LAS unsigned* st;
};

__device__ __forceinline__ XcdBarrier xcd_barrier_post(unsigned* bar, volatile LAS unsigned* st) {
    XcdBarrier b; b.bar = bar; b.x = xb_xcc_id(); b.st = st;
    if (threadIdx.x == 0) (void)xb_add(&bar[XB_XCNT(b.x)], 1u);
    return b;
}
__device__ __forceinline__ void xcd_barrier_complete(unsigned* bar, unsigned x, unsigned& nloc, unsigned& nx) {
    const unsigned G = gridDim.x * gridDim.y * gridDim.z;
    unsigned sum, cnt, mine, sp = 0u;
    for (;;) {
        sum = 0u; cnt = 0u; mine = 0u;
#pragma unroll
        for (unsigned j = 0; j < 16; ++j) { const unsigned c = xb_ld(&bar[XB_XCNT(j)]); sum += c; cnt += (c > 0u) ? 1u : 0u; mine = (j == x) ? c : mine; }
        if (sum == G) break;
        __builtin_amdgcn_s_sleep(1);
        if ((++sp & 255u) == 0u) { if (xb_ld(&bar[XB_TMO])) break; if (sp > XB_SPIN_CAP) { atomicAdd(&bar[XB_TMO], 1u); break; } }
    }
    nloc = mine > 0u ? mine : 1u; nx = cnt > 0u ? cnt : 1u;
}

__device__ __forceinline__ void xcd_barrier(const XcdBarrier& b) {
    asm volatile("s_waitcnt vmcnt(0)" ::: "memory");
    __syncthreads();
    if (threadIdx.x == 0) {
        unsigned* bar = b.bar;
        __builtin_amdgcn_s_waitcnt(0);
        unsigned nloc = b.st[0], nx = b.st[1];
        if (nloc == 0u) { xcd_barrier_complete(bar, b.x, nloc, nx); b.st[0] = nloc; b.st[1] = nx; }
        const unsigned old = xb_add(&bar[XB_XSUB(b.x)], 1u);
        const unsigned gen = old / nloc;
        if (old + 1u == (gen + 1u) * nloc) {
            __builtin_amdgcn_fence(__ATOMIC_RELEASE, "agent");
            asm volatile("s_waitcnt vmcnt(0)" ::: "memory");
            const unsigned og = xb_add(&bar[XB_TOP], 1u);
            const unsigned tg = og / nx;
            if (og + 1u == (tg + 1u) * nx) xb_add(&bar[XB_TOPGEN], 1u);
            else XB_SPIN(xb_ld(&bar[XB_TOPGEN]) == tg, bar);
            __builtin_amdgcn_fence(__ATOMIC_ACQUIRE, "agent");
            xb_add(&bar[XB_XGEN(b.x)], 1u);
            asm volatile("s_waitcnt vmcnt(0)" ::: "memory");
        } else {
            XB_SPIN(xb_ld(&bar[XB_XGEN(b.x)]) == gen, bar);
            __builtin_amdgcn_fence(__ATOMIC_ACQUIRE, "agent");
            asm volatile("s_waitcnt vmcnt(0)" ::: "memory");
        }
    }
    __syncthreads();
}

__global__ void __launch_bounds__(NTHREADS, 2) fwd_mega(Args a) {
    extern __shared__ __attribute__((aligned(16))) unsigned char lds[];
    cg::grid_group grid = cg::this_grid();
    volatile LAS unsigned* bst = (volatile LAS unsigned*)((LAS unsigned char*)lds + LDS_BYTES - 16);
    if (threadIdx.x < 4) bst[threadIdx.x] = 0u;
    __syncthreads();
    XcdBarrier bar = xcd_barrier_post((unsigned*)a.ws, bst);
    const int G = gridDim.x, tid = threadIdx.x, lane = tid & 63, wave = tid >> 6;
    const int lo = a.ph_lo, hi = a.ph_hi;
    unsigned char* ws = a.ws;
    bf16* P = (bf16*)(ws + WS_P); bf16* Yb = (bf16*)(ws + WS_Y);
#define IN(k) (lo <= (k) && (k) < hi)
#define SEAM(k) do { if (IN(k) && IN((k) + 1)) { if (lo < 0) grid.sync(); xcd_barrier(bar); } } while (0)
#ifndef SKIP_P0
    if (IN(0)) p0_prologue(lds, a, G);
#if REP_P0 > 1
    if (IN(0)) p0_prologue(lds, a, G);
#endif
#endif
    SEAM(0);
#ifndef SKIP_P1
    if (IN(1)) {
        pg8::Gemm g{(const pg8::bf16_t*)(ws + WS_XB), (const pg8::bf16_t*)(ws + WS_WIN), M, NPROJ, D};
        pg8::RepOrder<REP_P1> S; S.init(M, NPROJ, G, (int)blockIdx.x);
        pg8::EpiIn E{(pg8::bf16_t*)P, (const float*)(ws + WS_BIAS), (const float*)(ws + WS_RSTD), PBUF};
        pg8::gemm_phase<pg8::EpiIn, pg8::RepOrder<REP_P1>, true, true>((PG8_LAS unsigned char*)lds, g, S, E);
    }
#endif
    SEAM(1);
    if (IN(2)) {
        const int vcu = (G % 8 == 0) ? (int)(blockIdx.x % 8) * (G / 8) + (int)blockIdx.x / 8 : (int)blockIdx.x;
#ifndef REP_CONV
#define REP_CONV 1
#endif
#ifndef REP_ATTN
#define REP_ATTN 1
#endif
#ifndef SKIP_CONV
        for (int u = vcu; u < 512; u += G) {
            conv_unit(lds, u, P, P + PBUF, a.in[4], a.in[5], a.in[6], a.in[7], (const bf16*)(ws + WS_PW), a.in[9], a.in[11], Yb);
#if REP_CONV > 1
            conv_unit(lds, u, P, P + PBUF, a.in[4], a.in[5], a.in[6], a.in[7], (const bf16*)(ws + WS_PW), a.in[9], a.in[11], Yb);
#endif
        }
#endif
#ifndef SKIP_ATTN
        for (int u = vcu; u < 1024; u += G) {
            attn_unit(lds, u, P + 2 * PBUF, P + 3 * PBUF, P + 4 * PBUF, P + 5 * PBUF, a.in[10], a.in[12], Yb);
#if REP_ATTN > 1
            attn_unit(lds, u, P + 2 * PBUF, P + 3 * PBUF, P + 4 * PBUF, P + 5 * PBUF, a.in[10], a.in[12], Yb);
#endif
        }
#endif
    }
    SEAM(2);
#ifndef SKIP_P3
    if (IN(3)) {
        pg8::Gemm g{(const pg8::bf16_t*)Yb, (const pg8::bf16_t*)(ws + WS_WOUT), M, D, D};
        pg8::RepOrder<REP_P3> S; S.init(M, D, G, (int)blockIdx.x);
        pg8::EpiOut E{a.in[0], a.out, (float*)(ws + WS_SSP)};
        pg8::gemm_phase<pg8::EpiOut, pg8::RepOrder<REP_P3>, true, true>((PG8_LAS unsigned char*)lds, g, S, E);
    }
#endif
    SEAM(3);
    if (IN(4)) {
        const float* ssp = (const float*)(ws + WS_SSP); const float* fg = a.in[14];
        f32x4 gv[4];
#pragma unroll
        for (int j = 0; j < 4; ++j) gv[j] = *((const f32x4*)fg + lane + 64 * j);
        for (int m = blockIdx.x * NWAVES + wave; m < M; m += G * NWAVES) {
            float s = (lane < 16) ? ssp[(size_t)m * 16 + lane] : 0.f;
            s = wave_sum(s);
            const float rstd = 1.0f / sqrtf(s * (1.0f / D) + EPS);
            f32x4* o = (f32x4*)(a.out + (size_t)m * D) + lane;
#pragma unroll
            for (int j = 0; j < 4; ++j) { f32x4 v = o[64 * j]; v = v * rstd * gv[j]; o[64 * j] = v; }
        }
    }
#undef IN
#undef SEAM
}

extern "C" void kernel_launch(void* const* d_in, const int* in_sizes, int n_in, void* d_out, int out_size, void* d_ws, size_t ws_size, hipStream_t stream) {
    static int grid = 0;
    if (grid == 0) {
        if (n_in != 15 || in_sizes[0] != M * D || out_size != M * D || ws_size < WS_END) { fprintf(stderr, "kernel_launch: unexpected shapes (n_in %d, in0 %d, out %d, ws %zu)\n", n_in, n_in > 0 ? in_sizes[0] : -1, out_size, ws_size); grid = -1; return; }
        int dev = 0, cus = 0, per_cu = 0;
        hipGetDevice(&dev);
        hipDeviceGetAttribute(&cus, hipDeviceAttributeMultiprocessorCount, dev);
        if (hipFuncSetAttribute((const void*)fwd_mega, hipFuncAttributeMaxDynamicSharedMemorySize, LDS_BYTES) != hipSuccess) { fprintf(stderr, "kernel_launch: hipFuncSetAttribute failed\n"); grid = -1; return; }
        if (hipOccupancyMaxActiveBlocksPerMultiprocessor(&per_cu, (const void*)fwd_mega, NTHREADS, LDS_BYTES) != hipSuccess || per_cu < 1) { fprintf(stderr, "kernel_launch: occupancy query says %d blocks per CU\n", per_cu); per_cu = 1; }
        (void)hipGetLastError();
        grid = cus * per_cu;
    }
    if (grid < 0) return;
    if (hipMemsetAsync(d_ws, 0, 16384, stream) != hipSuccess) { fprintf(stderr, "kernel_launch: hipMemsetAsync failed\n"); return; }
    Args a{};
    for (int i = 0; i < 15; ++i) a.in[i] = (const float*)d_in[i];
    a.out = (float*)d_out; a.ws = (unsigned char*)d_ws;
#if MK_LAUNCHES == 1
    a.ph_lo = 0; a.ph_hi = 5;
    void* args[] = {&a};
    hipError_t e = hipLaunchCooperativeKernel((const void*)fwd_mega, dim3(grid), dim3(NTHREADS), args, LDS_BYTES, stream);
    if (e != hipSuccess) fprintf(stderr, "kernel_launch: cooperative launch failed: %s (grid %d)\n", hipGetErrorString(e), grid);
#else
    for (int k = 0; k < 5; ++k) {
        a.ph_lo = k; a.ph_hi = k + 1;
        hipLaunchKernelGGL(fwd_mega, dim3(grid), dim3(NTHREADS), LDS_BYTES, stream, a);
    }
#endif
}
```

```cpp
#include <hip/hip_runtime.h>
#include <hip/hip_cooperative_groups.h>
#include <cstdio>
#include <cstdint>
namespace cg = cooperative_groups;
namespace pg8 {
#define PG8_LAS __attribute__((address_space(3)))
typedef unsigned short bf16_t;
typedef short bf16x8 __attribute__((ext_vector_type(8)));
typedef float f32x4 __attribute__((ext_vector_type(4)));
typedef unsigned u32x4 __attribute__((ext_vector_type(4)));
constexpr int BM = 256, BK = 64, HALF = 128, HTB = HALF * BK * 2  , STAGE_BYTES = 8 * HTB, NXCD = 8, WGM = 8;

__host__ __device__ __forceinline__ int lds_byte(int r, int c) { const int st = (r >> 4) * 2 + (c >> 5), rr = r & 15, cc = c & 31, ob = rr * 64 + cc * 2; return st * 1024 + (ob ^ (((ob >> 9) & 1) << 5)); }
__host__ __device__ __forceinline__ void stage_rc(int b, int& R, int& C) { const int st = b / 1024, sb = b % 1024, swz = sb ^ (((sb >> 9) & 1) << 5); R = (st >> 1) * 16 + swz / 64; C = (st & 1) * 32 + (swz % 64) / 2; }
__host__ __device__ __forceinline__ int perm32(int rho) { const int n = rho >> 4, i = rho & 15; return 8 * (i >> 2) + 4 * n + (i & 3); }

struct Unit { int pm, pn; };
struct Gemm { const bf16_t* A; const bf16_t* Bt; int M, N, K; };

struct StaticOrder {
    int nM, nN, nwg, G, c;
    __host__ __device__ void init(int M, int N, int G_, int c_) { nM = M / BM; nN = N / BM; nwg = nM * nN; G = G_; c = c_; }
    __host__ __device__ bool next(int i, Unit& u) const {
        const long L = (long)i * G + c; if (L >= nwg) return false;
        int wgid = (int)L; { const int q = nwg / NXCD, r = nwg % NXCD, xcd = wgid % NXCD, off = wgid / NXCD; wgid = (xcd < r ? xcd * (q + 1) : r * (q + 1) + (xcd - r) * q) + off; }
        const int nig = WGM * nN, gid = wgid / nig, fm = gid * WGM, gsz = (nM - fm) < WGM ? (nM - fm) : WGM;
        u.pm = fm + ((wgid % nig) % gsz); u.pn = (wgid % nig) / gsz; return true;
    }
    __device__ __forceinline__ void a_ready(const Unit&) const {}
    __device__ __forceinline__ void done(const Unit&) const {}
};

template <int REP> struct RepOrder : StaticOrder {
    __host__ __device__ bool next(int i, Unit& u) const {
        if constexpr (REP > 1) { const int per = (nwg - c + G - 1) / G; if (i >= per * REP) return false; i %= per; }
        return StaticOrder::next(i, u);
    }
};
__device__ __forceinline__ unsigned cvt_pk_bf16(float lo, float hi) { unsigned r; asm volatile("v_cvt_pk_bf16_f32 %0, %1, %2" : "=v"(r) : "v"(lo), "v"(hi)); return r; }

__device__ __forceinline__ float sigmoidf_(float v) { return __builtin_amdgcn_rcpf(1.0f + __expf(-v)); }
struct EpiIn {
    static constexpr bool PERM = true, AFTER_DRAIN = false;
    bf16_t* P; const float* bias; const float* rstd; size_t bufstride;
    __device__ __forceinline__ void operator()(const f32x4 (&acc)[2][2][4][2], const Unit& u, int wr, int wc, int fr, int fq) const {
        const int row0 = u.pm * BM + wr * 64 + fr;
        const int cb = u.pn * BM + wc * 32 + 8 * fq;
        f32x4 bv[2][2];
#pragma unroll
        for (int bj = 0; bj < 2; ++bj)
#pragma unroll
            for (int n = 0; n < 2; ++n) bv[bj][n] = *(const f32x4*)(bias + cb + bj * HALF + 4 * n);
        if (u.pn < 4) {
            bf16_t* base = P + (128 * u.pn + wc * 32 + 8 * fq);
#pragma unroll
            for (int ai = 0; ai < 2; ++ai)
#pragma unroll
                for (int m = 0; m < 4; ++m) {
                    const int row = row0 + ai * HALF + m * 16; const float rs = rstd[row];
                    f32x4 a0 = acc[ai][0][m][0] * rs + bv[0][0], a1 = acc[ai][0][m][1] * rs + bv[0][1];
                    f32x4 b0 = acc[ai][1][m][0] * rs + bv[1][0], b1 = acc[ai][1][m][1] * rs + bv[1][1];
#pragma unroll
                    for (int j = 0; j < 4; ++j) { a0[j] *= sigmoidf_(b0[j]); a1[j] *= sigmoidf_(b1[j]); }
                    u32x4 w; w.x = cvt_pk_bf16(a0[0], a0[1]); w.y = cvt_pk_bf16(a0[2], a0[3]); w.z = cvt_pk_bf16(a1[0], a1[1]); w.w = cvt_pk_bf16(a1[2], a1[3]);
                    *(u32x4*)(base + (size_t)row * 512) = w;
                }
        } else {
            const int t = (u.pn - 4) >> 1;
            bf16_t* base = P + (size_t)(t + 1) * bufstride + ((u.pn - 4) & 1) * 256 + wc * 32 + 8 * fq;
            const bool gate = (t == 0) || (t == 4); const float sc = (t == 1) ? 0.125f : 1.0f;
#pragma unroll
            for (int ai = 0; ai < 2; ++ai)
#pragma unroll
                for (int m = 0; m < 4; ++m) {
                    const int row = row0 + ai * HALF + m * 16; const float rs = rstd[row];
#pragma unroll
                    for (int bj = 0; bj < 2; ++bj) {
                        f32x4 v0 = acc[ai][bj][m][0] * rs + bv[bj][0], v1 = acc[ai][bj][m][1] * rs + bv[bj][1];
                        if (gate) {
#pragma unroll
                            for (int j = 0; j < 4; ++j) { v0[j] *= sigmoidf_(v0[j]); v1[j] *= sigmoidf_(v1[j]); }
                        }
                        v0 = v0 * sc; v1 = v1 * sc;
                        u32x4 w; w.x = cvt_pk_bf16(v0[0], v0[1]); w.y = cvt_pk_bf16(v0[2], v0[3]); w.z = cvt_pk_bf16(v1[0], v1[1]); w.w = cvt_pk_bf16(v1[2], v1[3]);
                        *(u32x4*)(base + (size_t)row * 512 + bj * HALF) = w;
                    }
                }
        }
    }
};
struct EpiOut {
    static constexpr bool PERM = true, AFTER_DRAIN = false;
    const float* x; float* out; float* sspart;
    __device__ __forceinline__ void operator()(const f32x4 (&acc)[2][2][4][2], const Unit& u, int wr, int wc, int fr, int fq) const {
        const int row0 = u.pm * BM + wr * 64 + fr;
        const int col0 = u.pn * BM + wc * 32 + 8 * fq;
#pragma unroll
        for (int ai = 0; ai < 2; ++ai)
#pragma unroll
            for (int m = 0; m < 4; ++m) {
                const int row = row0 + ai * HALF + m * 16; float ss = 0.f;
#pragma unroll
                for (int bj = 0; bj < 2; ++bj) {
                    const size_t off = (size_t)row * 1024 + col0 + bj * HALF;
                    const f32x4 x0 = *(const f32x4*)(x + off), x1 = *(const f32x4*)(x + off + 4);
                    const f32x4 h0 = x0 + acc[ai][bj][m][0], h1 = x1 + acc[ai][bj][m][1];
                    *(f32x4*)(out + off) = h0; *(f32x4*)(out + off + 4) = h1;
                    ss += (h0[0] * h0[0] + h0[1] * h0[1]) + (h0[2] * h0[2] + h0[3] * h0[3]) + (h1[0] * h1[0] + h1[1] * h1[1]) + (h1[2] * h1[2] + h1[3] * h1[3]);
                }
                ss += __shfl_xor(ss, 16); ss += __shfl_xor(ss, 32);
                if (fq == 0) sspart[(size_t)row * 16 + u.pn * 4 + wc] = ss;
            }
    }
};

template <class Epi, class Sched, bool ALIGN_EPI = false, bool SP2 = false>
__device__ __forceinline__ void gemm_phase(PG8_LAS unsigned char* lds, const Gemm g, const Sched& S, const Epi& E) {
    const int tid = threadIdx.x, wid = __builtin_amdgcn_readfirstlane(tid >> 6), lane = tid & 63, wr = wid >> 2, wc = wid & 3, fr = lane & 15, fq = lane >> 4;
    const int K = g.K, nt = K / BK;
    unsigned voffA[2], voffB[2];
#pragma unroll
    for (int i = 0; i < 2; ++i) { int R, C; stage_rc(tid * 16 + i * 8192, R, C); const int Rb = Epi::PERM ? ((R & ~31) + perm32(R & 31)) : R;
        voffA[i] = (unsigned)(R * K + C) * 2u; voffB[i] = (unsigned)(Rb * K + C) * 2u; }
    const size_t kstep = (size_t)(BK * 2);
    const size_t hstep = (size_t)HALF * K * 2;
    const size_t tstep = 2 * hstep;
    const unsigned ldsw = (unsigned)wid * 1024u;
    const int aoff = lds_byte(wr * 64 + fr, fq * 8), boff = lds_byte(wc * 32 + fr, fq * 8);
#define PG8_SA(b, h) (((b) * 2 + (h)) * HTB)
#define PG8_SB(b, h) ((4 + (b) * 2 + (h)) * HTB)
#define PG8_STAGE(bufoff, gbase, voff) do { _Pragma("unroll") for (int _i = 0; _i < 2; ++_i) \
        __builtin_amdgcn_global_load_lds((const unsigned*)((const char*)(gbase) + (voff)[_i]), (PG8_LAS unsigned*)(lds + (bufoff) + ldsw + _i * 8192), 16, 0, 0); } while (0)
#define PG8_LDA(dst, b, h) do { _Pragma("unroll") for (int m = 0; m < 4; ++m) _Pragma("unroll") for (int k = 0; k < 2; ++k) dst[m][k] = *(const PG8_LAS bf16x8*)(lds + PG8_SA(b, h) + aoff + m * 2048 + k * 1024); } while (0)
#define PG8_LDB(dst, b, h) do { _Pragma("unroll") for (int n = 0; n < 2; ++n) _Pragma("unroll") for (int k = 0; k < 2; ++k) dst[n][k] = *(const PG8_LAS bf16x8*)(lds + PG8_SB(b, h) + boff + n * 2048 + k * 1024); } while (0)
#define PG8_MMA(ai, bj, At, Bt) do { __builtin_amdgcn_s_setprio(1); _Pragma("unroll") for (int m = 0; m < 4; ++m) _Pragma("unroll") for (int n = 0; n < 2; ++n) _Pragma("unroll") for (int k = 0; k < 2; ++k) \
        acc[ai][bj][m][n] = __builtin_amdgcn_mfma_f32_16x16x32_bf16(Bt[n][k], At[m][k], acc[ai][bj][m][n], 0, 0, 0); __builtin_amdgcn_s_setprio(0); } while (0)
#define PG8_WAIT_V(n) asm volatile("s_waitcnt vmcnt(" #n ")" ::: "memory")
#define PG8_WAIT_L(n) asm volatile("s_waitcnt lgkmcnt(" #n ")" ::: "memory")
#define PG8_BAR __builtin_amdgcn_s_barrier()
#define PG8_SCHED __builtin_amdgcn_sched_barrier(0)
    Unit cur, nxt; int ui = 0;
    if (!S.next(0, cur)) return;
    f32x4 acc[2][2][4][2];
#pragma unroll
    for (int a = 0; a < 2; ++a)
#pragma unroll
        for (int b = 0; b < 2; ++b)
#pragma unroll
            for (int m = 0; m < 4; ++m)
#pragma unroll
                for (int n = 0; n < 2; ++n) acc[a][b][m][n] = (f32x4){0.f, 0.f, 0.f, 0.f};
    bf16x8 At[4][2], B0[2][2], B1[2][2];
    const char* cA = (const char*)g.A + (size_t)cur.pm * tstep; const char* cB = (const char*)g.Bt + (size_t)cur.pn * tstep;
    S.a_ready(cur);
    if constexpr (SP2) {
        PG8_STAGE(PG8_SB(0, 0), cB, voffB); PG8_STAGE(PG8_SB(0, 1), cB + hstep, voffB); PG8_STAGE(PG8_SA(0, 0), cA, voffA); PG8_STAGE(PG8_SA(0, 1), cA + hstep, voffA);
        if (wr == 1) PG8_BAR;
        PG8_WAIT_V(2); PG8_BAR;
        PG8_STAGE(PG8_SB(1, 0), cB + kstep, voffB); PG8_STAGE(PG8_SA(1, 0), cA + kstep, voffA); PG8_STAGE(PG8_SB(1, 1), cB + hstep + kstep, voffB);
        PG8_WAIT_V(6); PG8_BAR;
    } else {
        PG8_STAGE(PG8_SB(0, 0), cB, voffB); PG8_STAGE(PG8_SA(0, 0), cA, voffA); PG8_STAGE(PG8_SB(0, 1), cB + hstep, voffB); PG8_STAGE(PG8_SA(0, 1), cA + hstep, voffA);
        if (wr == 1) PG8_BAR;
        PG8_WAIT_V(4); PG8_BAR;
        PG8_STAGE(PG8_SB(1, 0), cB + kstep, voffB); PG8_STAGE(PG8_SA(1, 0), cA + kstep, voffA); PG8_STAGE(PG8_SB(1, 1), cB + hstep + kstep, voffB);
        PG8_WAIT_V(6); PG8_BAR;
    }
    for (;;) {
        const bool has_next = S.next(ui + 1, nxt);
        const char* nA = has_next ? (const char*)g.A + (size_t)nxt.pm * tstep : cA; const char* nB = has_next ? (const char*)g.Bt + (size_t)nxt.pn * tstep : cB;
        for (int t = 0; t < nt; t += 2) {
            const bool last = (t == nt - 2);
            const char* a1 = cA + (size_t)(t + 1) * kstep;
            const char* a2 = last ? nA : cA + (size_t)(t + 2) * kstep; const char* b2 = last ? nB : cB + (size_t)(t + 2) * kstep;
            const char* a3 = a2 + kstep; const char* b3 = b2 + kstep;
            if (last && has_next) S.a_ready(nxt);
            if constexpr (SP2) {
            PG8_LDB(B0, 0, 0); PG8_LDB(B1, 0, 1); PG8_SCHED; PG8_LDA(At, 0, 0); PG8_STAGE(PG8_SA(1, 1), a1 + hstep, voffA);
            PG8_WAIT_V(8); PG8_WAIT_L(0); PG8_BAR; PG8_MMA(0, 0, At, B0); PG8_MMA(0, 1, At, B1); PG8_BAR; PG8_SCHED;
            PG8_LDA(At, 0, 1); PG8_STAGE(PG8_SB(0, 0), b2, voffB); PG8_STAGE(PG8_SB(0, 1), b2 + hstep, voffB); PG8_STAGE(PG8_SA(0, 0), a2, voffA);
            PG8_WAIT_V(8); PG8_WAIT_L(0); PG8_BAR; PG8_MMA(1, 0, At, B0); PG8_MMA(1, 1, At, B1); PG8_BAR; PG8_SCHED;
            PG8_LDB(B0, 1, 0); PG8_LDB(B1, 1, 1); PG8_SCHED; PG8_LDA(At, 1, 0); PG8_STAGE(PG8_SA(0, 1), a2 + hstep, voffA);
            PG8_WAIT_V(8); PG8_WAIT_L(0); PG8_BAR; PG8_MMA(0, 0, At, B0); PG8_MMA(0, 1, At, B1); PG8_BAR; PG8_SCHED;
            PG8_LDA(At, 1, 1); PG8_STAGE(PG8_SB(1, 0), b3, voffB); PG8_STAGE(PG8_SB(1, 1), b3 + hstep, voffB); PG8_STAGE(PG8_SA(1, 0), a3, voffA);
            PG8_WAIT_V(8); PG8_WAIT_L(0); PG8_BAR; PG8_MMA(1, 0, At, B0); PG8_MMA(1, 1, At, B1); PG8_BAR; PG8_SCHED;
            } else {
            PG8_LDB(B0, 0, 0); PG8_SCHED; PG8_LDA(At, 0, 0); PG8_STAGE(PG8_SA(1, 1), a1 + hstep, voffA);
            PG8_WAIT_L(8); PG8_BAR; PG8_WAIT_L(0); PG8_MMA(0, 0, At, B0); PG8_BAR; PG8_SCHED;
            PG8_LDB(B1, 0, 1); PG8_STAGE(PG8_SB(0, 0), b2, voffB);
            PG8_BAR; PG8_WAIT_L(0); PG8_MMA(0, 1, At, B1); PG8_BAR;
            PG8_LDA(At, 0, 1); PG8_STAGE(PG8_SA(0, 0), a2, voffA);
            PG8_BAR; PG8_WAIT_L(0); PG8_MMA(1, 0, At, B0); PG8_BAR; PG8_SCHED;
            PG8_STAGE(PG8_SB(0, 1), b2 + hstep, voffB);
            PG8_WAIT_V(6); PG8_BAR; PG8_MMA(1, 1, At, B1); PG8_BAR;
            PG8_LDB(B0, 1, 0); PG8_SCHED; PG8_LDA(At, 1, 0); PG8_STAGE(PG8_SA(0, 1), a2 + hstep, voffA);
            PG8_WAIT_L(8); PG8_BAR; PG8_WAIT_L(0); PG8_MMA(0, 0, At, B0); PG8_BAR; PG8_SCHED;
            PG8_LDB(B1, 1, 1); PG8_STAGE(PG8_SB(1, 0), b3, voffB);
            PG8_BAR; PG8_WAIT_L(0); PG8_MMA(0, 1, At, B1); PG8_BAR;
            PG8_LDA(At, 1, 1); PG8_STAGE(PG8_SA(1, 0), a3, voffA);
            PG8_BAR; PG8_WAIT_L(0); PG8_MMA(1, 0, At, B0); PG8_BAR; PG8_SCHED;
            PG8_STAGE(PG8_SB(1, 1), b3 + hstep, voffB);
            PG8_WAIT_V(6); PG8_BAR; PG8_MMA(1, 1, At, B1); PG8_BAR;
            }
        }
        if constexpr (ALIGN_EPI) { if (wr == 0) PG8_BAR; }
        if constexpr (!Epi::AFTER_DRAIN) { E(acc, cur, wr, wc, fr, fq); S.done(cur); }
        if (!has_next) break;
#pragma unroll
        for (int a = 0; a < 2; ++a)
#pragma unroll
            for (int b = 0; b < 2; ++b)
#pragma unroll
                for (int m = 0; m < 4; ++m)
#pragma unroll
                    for (int n = 0; n < 2; ++n) acc[a][b][m][n] = (f32x4){0.f, 0.f, 0.f, 0.f};
        cur = nxt; cA = nA; cB = nB; ++ui;
        if constexpr (ALIGN_EPI) { if (wr == 1) PG8_BAR; }
    }
    PG8_WAIT_V(0);
    if constexpr (!ALIGN_EPI) { if (wr == 0) PG8_BAR; }
    PG8_BAR;
    if constexpr (Epi::AFTER_DRAIN) { E.fused(acc, cur, wr, wc, fr, fq, lds, wid, lane); S.done(cur); }
#undef PG8_SA
#undef PG8_SB
#undef PG8_STAGE
#undef PG8_LDA
#undef PG8_LDB
#undef PG8_MMA
#undef PG8_WAIT_V
#undef PG8_WAIT_L
#undef PG8_BAR
#undef PG8_SCHED
}
}

#ifndef MK_LAUNCHES
#define MK_LAUNCHES 1
#endif
#ifndef REP_P0
#define REP_P0 1
#endif
#ifndef REP_P1
#define REP_P1 1
#endif
#ifndef REP_P3
#define REP_P3 1
#endif
typedef unsigned short bf16;
typedef short bf16x8 __attribute__((ext_vector_type(8)));
typedef short s16x4 __attribute__((ext_vector_type(4)));
typedef float f32x4 __attribute__((ext_vector_type(4)));
typedef float f32x16 __attribute__((ext_vector_type(16)));
typedef unsigned u32x4 __attribute__((ext_vector_type(4)));
typedef unsigned u32x2 __attribute__((ext_vector_type(2)));
#define LASX __attribute__((address_space(3)))

constexpr int BATCH = 2, SEQ = 8192, D = 1024, M = BATCH * SEQ, NPROJ = 3584;
constexpr float EPS = 1e-6f;
constexpr size_t MiB = 1u << 20;
constexpr size_t WS_WIN = 1 * MiB, WS_WOUT = 9 * MiB, WS_PW = 11 * MiB, WS_BIAS = 12 * MiB, WS_RSTD = 12 * MiB + 65536, WS_SSP = 13 * MiB;
constexpr size_t WS_XB = 16 * MiB, WS_P = 48 * MiB, WS_Y = 144 * MiB, WS_END = 176 * MiB;
constexpr size_t PBUF = (size_t)M * 512;
constexpr int LDS_BYTES = 147456;
constexpr int NTHREADS = 512, NWAVES = 8;

__device__ __forceinline__ float bf_lo(unsigned u) { return __builtin_bit_cast(float, u << 16); }
__device__ __forceinline__ float bf_hi(unsigned u) { return __builtin_bit_cast(float, u & 0xffff0000u); }
__device__ __forceinline__ unsigned pkbf(float lo, float hi) { unsigned r; asm("v_cvt_pk_bf16_f32 %0, %1, %2" : "=v"(r) : "v"(lo), "v"(hi)); return r; }
__device__ __forceinline__ float wave_sum(float v) {
#pragma unroll
    for (int o = 1; o < 64; o <<= 1) v += __shfl_xor(v, o);
    return v;
}
#define LDS_WAIT() asm volatile("s_waitcnt lgkmcnt(0)" ::: "memory")

__device__ __forceinline__ int colmap(int n) {
    if (n >= 1024) return n;
    if (n < 512) return 256 * (n >> 7) + (n & 127);
    n -= 512; return 256 * (n >> 7) + 128 + (n & 127);
}
__device__ __forceinline__ void transpose_item(const float* __restrict__ W, const float* __restrict__ g, int K, int N, bf16* WT, int mode, float* scr, int item, int lane) {
    const int nblk = N / 32, kb = item / nblk, nb = item % nblk, k0 = 64 * kb, n0 = 32 * nb;
#pragma unroll 8
    for (int i = 0; i < 32; ++i) { const int kk = 2 * i + (lane >> 5); float v = W[(size_t)(k0 + kk) * N + n0 + (lane & 31)]; if (g) v *= g[k0 + kk]; scr[kk * 33 + (lane & 31)] = v; }
    LDS_WAIT();
    const int c = lane & 7; const int row_off = (mode == 1) ? colmap(n0) : n0;
#pragma unroll
    for (int j = 0; j < 4; ++j) { const int n = (lane >> 3) + 8 * j; const float* s = scr + (8 * c) * 33 + n;
        u32x4 o; o.x = pkbf(s[0 * 33], s[1 * 33]); o.y = pkbf(s[2 * 33], s[3 * 33]); o.z = pkbf(s[4 * 33], s[5 * 33]); o.w = pkbf(s[6 * 33], s[7 * 33]);
        if (mode == 2) {
            const int k8 = (k0 >> 3) + c, T = nb, ks = k8 >> 1, ln = n + 32 * (k8 & 1);
            *(u32x4*)(WT + ((size_t)(T * (K >> 4) + ks) * 64 + ln) * 8) = o;
        } else *(u32x4*)(WT + (size_t)(row_off + n) * K + k0 + 8 * c) = o; }
    LDS_WAIT();
}

struct Args { const float* in[15]; float* out; unsigned char* ws; int ph_lo, ph_hi; int pad0, pad1; };

__device__ __forceinline__ void p0_prologue(unsigned char* lds, const Args& a, int G) {
    const int tid = threadIdx.x, lane = tid & 63, wave = tid >> 6;
    const float* x = a.in[0]; const float* ln_g = a.in[1]; const float* w_in = a.in[2]; const float* b_in = a.in[3];
    const float* pw_w = a.in[8]; const float* w_out = a.in[13];
    bf16* Wt_in = (bf16*)(a.ws + WS_WIN); bf16* Wt_out = (bf16*)(a.ws + WS_WOUT); bf16* Wt_pw = (bf16*)(a.ws + WS_PW);
    float* biasp = (float*)(a.ws + WS_BIAS); float* rstd = (float*)(a.ws + WS_RSTD); bf16* XB = (bf16*)(a.ws + WS_XB);
    float* scr = (float*)(lds + wave * 16384);
    const int gw = blockIdx.x * NWAVES + wave, NGW = G * NWAVES;
    constexpr int I_IN = (D / 64) * (NPROJ / 32), I_OUT = (D / 64) * (D / 32), I_PW = (512 / 64) * (512 / 32);
    for (int it = gw; it < I_IN + I_OUT + I_PW; it += NGW) {
        int r = it;
        if (r < I_IN) { transpose_item(w_in, ln_g, D, NPROJ, Wt_in, 1, scr, r, lane); continue; } r -= I_IN;
        if (r < I_OUT) { transpose_item(w_out, nullptr, D, D, Wt_out, 0, scr, r, lane); continue; } r -= I_OUT;
        transpose_item(pw_w, nullptr, 512, 512, Wt_pw, 2, scr, r, lane);
    }
    for (int n = blockIdx.x * NTHREADS + tid; n < NPROJ; n += G * NTHREADS) biasp[colmap(n)] = b_in[n];
    for (int m = gw; m < M; m += NGW) {
        const f32x4* xr = (const f32x4*)(x + (size_t)m * D) + lane;
        f32x4 v[4]; float s = 0.f;
#pragma unroll
        for (int j = 0; j < 4; ++j) { v[j] = xr[64 * j]; s += (v[j].x * v[j].x + v[j].y * v[j].y) + (v[j].z * v[j].z + v[j].w * v[j].w); }
        s = wave_sum(s);
        if (lane == 0) rstd[m] = 1.0f / sqrtf(s * (1.0f / D) + EPS);
        u32x2* o8 = (u32x2*)(XB + (size_t)m * D) + lane;
#pragma unroll
        for (int j = 0; j < 4; ++j) { u32x2 o; o.x = pkbf(v[j].x, v[j].y); o.y = pkbf(v[j].z, v[j].w); o8[64 * j] = o; }
    }
}

constexpr int CV_W_PITCH = 144, CV_W_BYTES = 512 * CV_W_PITCH;
constexpr int CV_VN_OFF = CV_W_BYTES, CV_VN_PITCH = 1040;
static_assert(CV_VN_OFF + 32 * CV_VN_PITCH <= LDS_BYTES && 62 * 1024 <= CV_W_BYTES, "conv LDS map");

__device__ __forceinline__ void conv_unit(unsigned char* lds, int unit, const bf16* __restrict__ U, const bf16* __restrict__ ZC, const float* __restrict__ dw_w, const float* __restrict__ dw_b,
                                          const float* __restrict__ cln_g, const float* __restrict__ cln_b, const bf16* __restrict__ pw_t, const float* __restrict__ pw_b,
                                          const float* __restrict__ gn_g, bf16* __restrict__ Y) {
    int tid = threadIdx.x; asm volatile("" : "+v"(tid));
    const int lane = tid & 63, w = __builtin_amdgcn_readfirstlane(tid >> 6);
    const int b = unit >> 8, tok0 = (unit & 255) * 32;
    const size_t rowbase = (size_t)b * SEQ;
    {
        u32x4 hv[8];
#pragma unroll
        for (int i = 0; i < 8; ++i) {
            const int idx = tid + i * NTHREADS, row = idx >> 6, ch = idx & 63, t = tok0 - 15 + row;
            const int tc = min(max(t, 0), SEQ - 1);
            hv[i] = *(const u32x4*)(U + (rowbase + tc) * 512 + ch * 8);
            if (t < 0 || t >= SEQ) hv[i] = (u32x4){0u, 0u, 0u, 0u};
        }
#pragma unroll
        for (int i = 0; i < 8; ++i) { const int idx = tid + i * NTHREADS, row = idx >> 6, ch = idx & 63; if (row < 62) *(u32x4*)(lds + row * 1024 + ch * 16) = hv[i]; }
    }
    const int cp = tid & 255, th = tid >> 8;
    typedef float f32x2 __attribute__((ext_vector_type(2)));
    f32x2 wv[31];
#pragma unroll
    for (int j = 0; j < 31; ++j) wv[j] = *(const f32x2*)(dw_w + j * 512 + 2 * cp);
    const f32x2 bb = *(const f32x2*)(dw_b + 2 * cp);
    __syncthreads();
    {
#pragma unroll 1
        for (int hf = 0; hf < 2; ++hf) {
            f32x2 uv[38];
            const unsigned char* up = lds + (16 * th + 8 * hf) * 1024 + cp * 4;
#pragma unroll
            for (int i = 0; i < 38; ++i) { const unsigned uu = *(const unsigned*)(up + i * 1024); uv[i] = (f32x2){bf_lo(uu), bf_hi(uu)}; }
            unsigned char* vp = lds + CV_VN_OFF + (16 * th + 8 * hf) * CV_VN_PITCH + cp * 4;
#pragma unroll
            for (int o = 0; o < 8; ++o) {
                f32x2 acc2 = bb;
#pragma unroll
                for (int j = 0; j < 31; ++j) acc2 = __builtin_elementwise_fma(wv[j], uv[o + j], acc2);
                *(unsigned*)(vp + o * CV_VN_PITCH) = pkbf(acc2.x, acc2.y);
                if (o & 1) __builtin_amdgcn_sched_barrier(0);
            }
        }
    }
    __syncthreads();
    {
        const f32x4 g0 = *(const f32x4*)(cln_g + 8 * lane), g1 = *(const f32x4*)(cln_g + 8 * lane + 4);
        const f32x4 c0 = *(const f32x4*)(cln_b + 8 * lane), c1 = *(const f32x4*)(cln_b + 8 * lane + 4);
#pragma unroll
        for (int tt = 0; tt < 4; ++tt) {
            unsigned char* p = lds + CV_VN_OFF + (4 * w + tt) * CV_VN_PITCH + lane * 16;
            const u32x4 raw = *(const u32x4*)p;
            float v[8] = {bf_lo(raw.x), bf_hi(raw.x), bf_lo(raw.y), bf_hi(raw.y), bf_lo(raw.z), bf_hi(raw.z), bf_lo(raw.w), bf_hi(raw.w)};
            float s = 0.f;
#pragma unroll
            for (int e = 0; e < 8; ++e) s += v[e];
            const float mean = wave_sum(s) * (1.0f / 512.0f);
            float q = 0.f;
#pragma unroll
            for (int e = 0; e < 8; ++e) { v[e] -= mean; q += v[e] * v[e]; }
            const float rstd = 1.0f / sqrtf(wave_sum(q) * (1.0f / 512.0f) + EPS);
            const float gg[8] = {g0[0], g0[1], g0[2], g0[3], g1[0], g1[1], g1[2], g1[3]};
            const float cc[8] = {c0[0], c0[1], c0[2], c0[3], c1[0], c1[1], c1[2], c1[3]};
#pragma unroll
            for (int e = 0; e < 8; ++e) { const float n = v[e] * rstd * gg[e] + cc[e]; v[e] = n * pg8::sigmoidf_(n); }
            u32x4 o; o.x = pkbf(v[0], v[1]); o.y = pkbf(v[2], v[3]); o.z = pkbf(v[4], v[5]); o.w = pkbf(v[6], v[7]);
            *(u32x4*)p = o;
        }
    }
    __syncthreads();
    const int r32 = lane & 31, h2 = lane >> 5;
    f32x16 acc[2];
#pragma unroll
    for (int a = 0; a < 2; ++a)
#pragma unroll
        for (int e = 0; e < 16; ++e) acc[a][e] = 0.f;
    {
        const unsigned char* wp0 = (const unsigned char*)pw_t + (size_t)(2 * w) * 32768 + lane * 16;
        const unsigned char* wp1 = wp0 + 32768;
        const unsigned char* bp = lds + CV_VN_OFF + r32 * CV_VN_PITCH + 16 * h2;
        u32x4 wA[8], wB[8];
#define CV_LD(dst, off) do { _Pragma("unroll") for (int ss = 0; ss < 4; ++ss) { dst[2 * ss] = *(const u32x4*)(wp0 + (off) + ss * 1024); dst[2 * ss + 1] = *(const u32x4*)(wp1 + (off) + ss * 1024); } } while (0)
#define CV_MM(src, off) do { _Pragma("unroll") for (int ss = 0; ss < 4; ++ss) { const bf16x8 bfr = *(const bf16x8*)(bp + (off) + ss * 32); \
            acc[0] = __builtin_amdgcn_mfma_f32_32x32x16_bf16(__builtin_bit_cast(bf16x8, src[2 * ss]), bfr, acc[0], 0, 0, 0); \
            acc[1] = __builtin_amdgcn_mfma_f32_32x32x16_bf16(__builtin_bit_cast(bf16x8, src[2 * ss + 1]), bfr, acc[1], 0, 0, 0); } } while (0)
        CV_LD(wA, 0);
#pragma unroll 1
        for (int g2 = 0; g2 < 4; ++g2) {
            CV_LD(wB, 4096);
            CV_MM(wA, 0);
            wp0 += 8192; wp1 += 8192;
            if (g2 < 3) CV_LD(wA, 0);
            CV_MM(wB, 128);
            bp += 256;
        }
#undef CV_LD
#undef CV_MM
    }
    const size_t row = rowbase + tok0 + r32;
    float ss = 0.f;
#pragma unroll
    for (int a = 0; a < 2; ++a)
#pragma unroll
        for (int rg = 0; rg < 4; ++rg) {
            const f32x4 pb = *(const f32x4*)(pw_b + 64 * w + 32 * a + 8 * rg + 4 * h2);
#pragma unroll
            for (int j = 0; j < 4; ++j) { const float v = acc[a][4 * rg + j] + pb[j]; acc[a][4 * rg + j] = v; ss += v * v; }
        }
    ss += __shfl_xor(ss, 32);
    const float rstd = 1.0f / sqrtf(ss * (1.0f / 64.0f) + EPS);
#pragma unroll
    for (int a = 0; a < 2; ++a)
#pragma unroll
        for (int rg = 0; rg < 4; ++rg) {
            const int oc0 = 64 * w + 32 * a + 8 * rg + 4 * h2;
            const f32x4 g = *(const f32x4*)(gn_g + oc0);
            const u32x2 z = *(const u32x2*)(ZC + row * 512 + oc0);
            u32x2 o;
            o.x = pkbf(acc[a][4 * rg + 0] * rstd * g[0] * bf_lo(z.x), acc[a][4 * rg + 1] * rstd * g[1] * bf_hi(z.x));
            o.y = pkbf(acc[a][4 * rg + 2] * rstd * g[2] * bf_lo(z.y), acc[a][4 * rg + 3] * rstd * g[3] * bf_hi(z.y));
            *(u32x2*)(Y + row * 1024 + oc0) = o;
        }
    __syncthreads();
}

constexpr int AT_RPB_OFF = 2 * 8 * 64 * 128;
static_assert(AT_RPB_OFF + 2 * 465 * 4 <= LDS_BYTES - 16, "attention LDS map");
__device__ __forceinline__ s16x4 vtr(const unsigned char* p) {
    typedef short v4i16_t __attribute__((ext_vector_type(4)));
    return __builtin_bit_cast(s16x4, __builtin_amdgcn_ds_read_tr16_b64_v4i16((LASX v4i16_t*)p));
}
__device__ __forceinline__ void attn_unit(unsigned char* lds, int unit, const bf16* __restrict__ Q, const bf16* __restrict__ K, const bf16* __restrict__ V, const bf16* __restrict__ ZA,
                                          const float* __restrict__ rpb, const float* __restrict__ gn_g, bf16* __restrict__ Y) {
    int tid = threadIdx.x; asm volatile("" : "+v"(tid));
    const int lane = tid & 63, w = __builtin_amdgcn_readfirstlane(tid >> 6);
    const int b = unit >> 9, hp = (unit >> 7) & 3, r = unit & 127;
    const int rs = min(max(r - 4, 0), 120);
    const size_t rowbase = (size_t)b * SEQ;
#pragma unroll
    for (int hb = 0; hb < 2; ++hb) {
        u32x4 vv[8];
#pragma unroll
        for (int k = 0; k < 8; ++k) {
            const int idx = tid + (hb * 8 + k) * NTHREADS, tr = idx >> 4, c16 = idx & 15, i = tr >> 6, tok = tr & 63;
            vv[k] = *(const u32x4*)(V + (rowbase + (size_t)(rs + i) * 64 + tok) * 512 + hp * 128 + c16 * 8);
        }
#pragma unroll
        for (int k = 0; k < 8; ++k) {
            const int idx = tid + (hb * 8 + k) * NTHREADS, tr = idx >> 4, c16 = idx & 15, tok = tr & 63, head = c16 >> 3, ch = c16 & 7;
            *(u32x4*)(lds + head * 65536 + tr * 128 + (((ch >> 1) ^ ((tok >> 1) & 3)) << 5) + ((ch & 1) << 4)) = vv[k];
        }
    }
    for (int idx = tid; idx < 930; idx += NTHREADS) ((float*)(lds + AT_RPB_OFF))[idx] = rpb[hp * 930 + idx];
    __syncthreads();
    const int hl = w >> 2, c = w & 3, h = 2 * hp + hl;
    const int wc0 = (c == 0) ? 0 : (c == 1) ? 8 : (c == 2) ? 24 : 32;
    const int l16 = lane & 15, g = lane >> 4;
    const size_t tq = rowbase + (size_t)r * 64 + 16 * c + l16;
    const bf16x8 qf0 = *(const bf16x8*)(Q + tq * 512 + h * 64 + 8 * g), qf1 = *(const bf16x8*)(Q + tq * 512 + h * 64 + 32 + 8 * g);
    f32x4 st[8][2];
#pragma unroll
    for (int i = 0; i < 8; ++i)
#pragma unroll
        for (int hh = 0; hh < 2; ++hh) {
            const bf16* kp = K + (rowbase + (size_t)(rs + i) * 64 + wc0 + 16 * hh + l16) * 512 + h * 64 + 8 * g;
            const bf16x8 k0 = *(const bf16x8*)kp, k1 = *(const bf16x8*)(kp + 32);
            f32x4 z = {0.f, 0.f, 0.f, 0.f};
            z = __builtin_amdgcn_mfma_f32_16x16x32_bf16(k0, qf0, z, 0, 0, 0);
            z = __builtin_amdgcn_mfma_f32_16x16x32_bf16(k1, qf1, z, 0, 0, 0);
            st[i][hh] = z;
        }
    const int wq = 16 * c + l16, cs = min(max(wq - 8, 0), 48);
    const float* tbl = (const float*)(lds + AT_RPB_OFF) + hl * 465;
    float mx = -1e30f;
#pragma unroll
    for (int i = 0; i < 8; ++i) {
        const int rowoff = (rs + i - r + 7) * 31 - wq + 15;
#pragma unroll
        for (int hh = 0; hh < 2; ++hh)
#pragma unroll
            for (int j = 0; j < 4; ++j) {
                const int kc = wc0 + 16 * hh + 4 * g + j;
                const bool inw = (kc >= cs) && (kc < cs + 16);
                const float bias = tbl[inw ? rowoff + kc : 0];
                const float s = inw ? st[i][hh][j] + bias : -1e30f;
                st[i][hh][j] = s; mx = fmaxf(mx, s);
            }
    }
    mx = fmaxf(mx, __shfl_xor(mx, 16)); mx = fmaxf(mx, __shfl_xor(mx, 32));
    float sum = 0.f;
#pragma unroll
    for (int i = 0; i < 8; ++i)
#pragma unroll
        for (int hh = 0; hh < 2; ++hh)
#pragma unroll
            for (int j = 0; j < 4; ++j) { const float p = __builtin_amdgcn_exp2f((st[i][hh][j] - mx) * 1.4426950408889634f); st[i][hh][j] = p; sum += p; }
    sum += __shfl_xor(sum, 16); sum += __shfl_xor(sum, 32);
    const unsigned char* vb = lds + hl * 65536;
    const int qq = l16 >> 2, pp = l16 & 3;
    const int key0 = wc0 + 4 * g + qq, sw = (key0 >> 1) & 3;
    f32x4 o[4];
#pragma unroll
    for (int ht = 0; ht < 4; ++ht) o[ht] = (f32x4){0.f, 0.f, 0.f, 0.f};
#pragma unroll
    for (int i = 0; i < 8; ++i) {
        u32x4 pw; pw.x = pkbf(st[i][0][0], st[i][0][1]); pw.y = pkbf(st[i][0][2], st[i][0][3]); pw.z = pkbf(st[i][1][0], st[i][1][1]); pw.w = pkbf(st[i][1][2], st[i][1][3]);
        const bf16x8 pf = __builtin_bit_cast(bf16x8, pw);
#pragma unroll
        for (int ht = 0; ht < 4; ++ht) {
            const unsigned char* a0 = vb + (i * 64 + key0) * 128 + ((ht ^ sw) << 5) + 8 * pp;
            const s16x4 lo = vtr(a0), hi = vtr(a0 + 16 * 128);
            const bf16x8 vf = __builtin_shufflevector(lo, hi, 0, 1, 2, 3, 4, 5, 6, 7);
            o[ht] = __builtin_amdgcn_mfma_f32_16x16x32_bf16(vf, pf, o[ht], 0, 0, 0);
        }
    }
    const float inv = 1.0f / sum;
    float ss = 0.f;
#pragma unroll
    for (int ht = 0; ht < 4; ++ht)
#pragma unroll
        for (int j = 0; j < 4; ++j) { const float v = o[ht][j] * inv; o[ht][j] = v; ss += v * v; }
    ss += __shfl_xor(ss, 16); ss += __shfl_xor(ss, 32);
    const float rstd = 1.0f / sqrtf(ss * (1.0f / 64.0f) + EPS);
#pragma unroll
    for (int ht = 0; ht < 4; ++ht) {
        const int ch = h * 64 + 16 * ht + 4 * g;
        const f32x4 gg = *(const f32x4*)(gn_g + ch);
        const u32x2 z = *(const u32x2*)(ZA + tq * 512 + ch);
        u32x2 ov;
        ov.x = pkbf(o[ht][0] * rstd * gg[0] * bf_lo(z.x), o[ht][1] * rstd * gg[1] * bf_hi(z.x));
        ov.y = pkbf(o[ht][2] * rstd * gg[2] * bf_lo(z.y), o[ht][3] * rstd * gg[3] * bf_hi(z.y));
        *(u32x2*)(Y + tq * 1024 + 512 + ch) = ov;
    }
    __syncthreads();
}

#define LAS __attribute__((address_space(3)))
#define XB_TMO      128
#define XB_XCNT(j)  (256  + 64 * (j))
#define XB_XSUB(j)  (1280 + 64 * (j))
#define XB_XGEN(j)  (2304 + 64 * (j))
#define XB_TOP      3328
#define XB_TOPGEN   3392
#define XCD_BAR_WORDS 3456
#define XB_SPIN_CAP (1u << 18)

__device__ __forceinline__ unsigned xb_ld(unsigned* p)              { return __hip_atomic_load(p, __ATOMIC_RELAXED, __HIP_MEMORY_SCOPE_AGENT); }
__device__ __forceinline__ unsigned xb_add(unsigned* p, unsigned v) { return __hip_atomic_fetch_add(p, v, __ATOMIC_RELAXED, __HIP_MEMORY_SCOPE_AGENT); }
__device__ __forceinline__ unsigned xb_xcc_id() { return (unsigned)__builtin_amdgcn_s_getreg((3 << 11) | 20) & 0xFu; }
#define XB_SPIN(cond, bar) do { unsigned _sp = 0; while (cond) { __builtin_amdgcn_s_sleep(1); \
    if ((++_sp & 255u) == 0u) { if (xb_ld(&(bar)[XB_TMO])) break; if (_sp > XB_SPIN_CAP) { atomicAdd(&(bar)[XB_TMO], 1u); break; } } } } while (0)

struct XcdBarrier {
    unsigned* bar; unsigned x;
    volatile LAS unsigned* st;
};

__device__ __forceinline__ XcdBarrier xcd_barrier_post(unsigned* bar, volatile LAS unsigned* st) {
    XcdBarrier b; b.bar = bar; b.x = xb_xcc_id(); b.st = st;
    if (threadIdx.x == 0) (void)xb_add(&bar[XB_XCNT(b.x)], 1u);
    return b;
}
__device__ __forceinline__ void xcd_barrier_complete(unsigned* bar, unsigned x, unsigned& nloc, unsigned& nx) {
    const unsigned G = gridDim.x * gridDim.y * gridDim.z;
    unsigned sum, cnt, mine, sp = 0u;
    for (;;) {
        sum = 0u; cnt = 0u; mine = 0u;
#pragma unroll
        for (unsigned j = 0; j < 16; ++j) { const unsigned c = xb_ld(&bar[XB_XCNT(j)]); sum += c; cnt += (c > 0u) ? 1u : 0u; mine = (j == x) ? c : mine; }
        if (sum == G) break;
        __builtin_amdgcn_s_sleep(1);
        if ((++sp & 255u) == 0u) { if (xb_ld(&bar[XB_TMO])) break; if (sp > XB_SPIN_CAP) { atomicAdd(&bar[XB_TMO], 1u); break; } }
    }
    nloc = mine > 0u ? mine : 1u; nx = cnt > 0u ? cnt : 1u;
}

__device__ __forceinline__ void xcd_barrier(const XcdBarrier& b) {
    asm volatile("s_waitcnt vmcnt(0)" ::: "memory");
    __syncthreads();
    if (threadIdx.x == 0) {
        unsigned* bar = b.bar;
        __builtin_amdgcn_s_waitcnt(0);
        unsigned nloc = b.st[0], nx = b.st[1];
        if (nloc == 0u) { xcd_barrier_complete(bar, b.x, nloc, nx); b.st[0] = nloc; b.st[1] = nx; }
        const unsigned old = xb_add(&bar[XB_XSUB(b.x)], 1u);
        const unsigned gen = old / nloc;
        if (old + 1u == (gen + 1u) * nloc) {
            __builtin_amdgcn_fence(__ATOMIC_RELEASE, "agent");
            asm volatile("s_waitcnt vmcnt(0)" ::: "memory");
            const unsigned og = xb_add(&bar[XB_TOP], 1u);
            const unsigned tg = og / nx;
            if (og + 1u == (tg + 1u) * nx) xb_add(&bar[XB_TOPGEN], 1u);
            else XB_SPIN(xb_ld(&bar[XB_TOPGEN]) == tg, bar);
            __builtin_amdgcn_fence(__ATOMIC_ACQUIRE, "agent");
            xb_add(&bar[XB_XGEN(b.x)], 1u);
            asm volatile("s_waitcnt vmcnt(0)" ::: "memory");
        } else {
            XB_SPIN(xb_ld(&bar[XB_XGEN(b.x)]) == gen, bar);
            __builtin_amdgcn_fence(__ATOMIC_ACQUIRE, "agent");
            asm volatile("s_waitcnt vmcnt(0)" ::: "memory");
        }
    }
    __syncthreads();
}

__global__ void __launch_bounds__(NTHREADS, 2) fwd_mega(Args a) {
    extern __shared__ __attribute__((aligned(16))) unsigned char lds[];
    cg::grid_group grid = cg::this_grid();
    volatile LAS unsigned* bst = (volatile LAS unsigned*)((LAS unsigned char*)lds + LDS_BYTES - 16);
    if (threadIdx.x < 4) bst[threadIdx.x] = 0u;
    __syncthreads();
    XcdBarrier bar = xcd_barrier_post((unsigned*)a.ws, bst);
    const int G = gridDim.x, tid = threadIdx.x, lane = tid & 63, wave = tid >> 6;
    const int lo = a.ph_lo, hi = a.ph_hi;
    unsigned char* ws = a.ws;
    bf16* P = (bf16*)(ws + WS_P); bf16* Yb = (bf16*)(ws + WS_Y);
#define IN(k) (lo <= (k) && (k) < hi)
#define SEAM(k) do { if (IN(k) && IN((k) + 1)) { if (lo < 0) grid.sync(); xcd_barrier(bar); } } while (0)
#ifndef SKIP_P0
    if (IN(0)) p0_prologue(lds, a, G);
#if REP_P0 > 1
    if (IN(0)) p0_prologue(lds, a, G);
#endif
#endif
    SEAM(0);
#ifndef SKIP_P1
    if (IN(1)) {
        pg8::Gemm g{(const pg8::bf16_t*)(ws + WS_XB), (const pg8::bf16_t*)(ws + WS_WIN), M, NPROJ, D};
        pg8::RepOrder<REP_P1> S; S.init(M, NPROJ, G, (int)blockIdx.x);
        pg8::EpiIn E{(pg8::bf16_t*)P, (const float*)(ws + WS_BIAS), (const float*)(ws + WS_RSTD), PBUF};
        pg8::gemm_phase<pg8::EpiIn, pg8::RepOrder<REP_P1>, true, true>((PG8_LAS unsigned char*)lds, g, S, E);
    }
#endif
    SEAM(1);
    if (IN(2)) {
        const int vcu = (G % 8 == 0) ? (int)(blockIdx.x % 8) * (G / 8) + (int)blockIdx.x / 8 : (int)blockIdx.x;
#ifndef REP_CONV
#define REP_CONV 1
#endif
#ifndef REP_ATTN
#define REP_ATTN 1
#endif
#ifndef SKIP_CONV
        for (int u = vcu; u < 512; u += G) {
            conv_unit(lds, u, P, P + PBUF, a.in[4], a.in[5], a.in[6], a.in[7], (const bf16*)(ws + WS_PW), a.in[9], a.in[11], Yb);
#if REP_CONV > 1
            conv_unit(lds, u, P, P + PBUF, a.in[4], a.in[5], a.in[6], a.in[7], (const bf16*)(ws + WS_PW), a.in[9], a.in[11], Yb);
#endif
        }
#endif
#ifndef SKIP_ATTN
        for (int u = vcu; u < 1024; u += G) {
            attn_unit(lds, u, P + 2 * PBUF, P + 3 * PBUF, P + 4 * PBUF, P + 5 * PBUF, a.in[10], a.in[12], Yb);
#if REP_ATTN > 1
            attn_unit(lds, u, P + 2 * PBUF, P + 3 * PBUF, P + 4 * PBUF, P + 5 * PBUF, a.in[10], a.in[12], Yb);
#endif
        }
#endif
    }
    SEAM(2);
#ifndef SKIP_P3
    if (IN(3)) {
        pg8::Gemm g{(const pg8::bf16_t*)Yb, (const pg8::bf16_t*)(ws + WS_WOUT), M, D, D};
        pg8::RepOrder<REP_P3> S; S.init(M, D, G, (int)blockIdx.x);
        pg8::EpiOut E{a.in[0], a.out, (float*)(ws + WS_SSP)};
        pg8::gemm_phase<pg8::EpiOut, pg8::RepOrder<REP_P3>, true, true>((PG8_LAS unsigned char*)lds, g, S, E);
    }
#endif
    SEAM(3);
    if (IN(4)) {
        const float* ssp = (const float*)(ws + WS_SSP); const float* fg = a.in[14];
        f32x4 gv[4];
#pragma unroll
        for (int j = 0; j < 4; ++j) gv[j] = *((const f32x4*)fg + lane + 64 * j);
        for (int m = blockIdx.x * NWAVES + wave; m < M; m += G * NWAVES) {
            float s = (lane < 16) ? ssp[(size_t)m * 16 + lane] : 0.f;
            s = wave_sum(s);
            const float rstd = 1.0f / sqrtf(s * (1.0f / D) + EPS);
            f32x4* o = (f32x4*)(a.out + (size_t)m * D) + lane;
#pragma unroll
            for (int j = 0; j < 4; ++j) { f32x4 v = o[64 * j]; v = v * rstd * gv[j]; o[64 * j] = v; }
        }
    }
#undef IN
#undef SEAM
}

extern "C" void kernel_launch(void* const* d_in, const int* in_sizes, int n_in, void* d_out, int out_size, void* d_ws, size_t ws_size, hipStream_t stream) {
    static int grid = 0;
    if (grid == 0) {
        if (n_in != 15 || in_sizes[0] != M * D || out_size != M * D || ws_size < WS_END) { fprintf(stderr, "kernel_launch: unexpected shapes (n_in %d, in0 %d, out %d, ws %zu)\n", n_in, n_in > 0 ? in_sizes[0] : -1, out_size, ws_size); grid = -1; return; }
        int dev = 0, cus = 0, per_cu = 0;
        hipGetDevice(&dev);
        hipDeviceGetAttribute(&cus, hipDeviceAttributeMultiprocessorCount, dev);
        if (hipFuncSetAttribute((const void*)fwd_mega, hipFuncAttributeMaxDynamicSharedMemorySize, LDS_BYTES) != hipSuccess) { fprintf(stderr, "kernel_launch: hipFuncSetAttribute failed\n"); grid = -1; return; }
        if (hipOccupancyMaxActiveBlocksPerMultiprocessor(&per_cu, (const void*)fwd_mega, NTHREADS, LDS_BYTES) != hipSuccess || per_cu < 1) { fprintf(stderr, "kernel_launch: occupancy query says %d blocks per CU\n", per_cu); per_cu = 1; }
        (void)hipGetLastError();
        grid = cus * per_cu;
    }
    if (grid < 0) return;
    if (hipMemsetAsync(d_ws, 0, 16384, stream) != hipSuccess) { fprintf(stderr, "kernel_launch: hipMemsetAsync failed\n"); return; }
    Args a{};
    for (int i = 0; i < 15; ++i) a.in[i] = (const float*)d_in[i];
    a.out = (float*)d_out; a.ws = (unsigned char*)d_ws;
#if MK_LAUNCHES == 1
    a.ph_lo = 0; a.ph_hi = 5;
    void* args[] = {&a};
    hipError_t e = hipLaunchCooperativeKernel((const void*)fwd_mega, dim3(grid), dim3(NTHREADS), args, LDS_BYTES, stream);
    if (e != hipSuccess) fprintf(stderr, "kernel_launch: cooperative launch failed: %s (grid %d)\n", hipGetErrorString(e), grid);
#else
    for (int k = 0; k < 5; ++k) {
        a.ph_lo = k; a.ph_hi = k + 1;
        hipLaunchKernelGGL(fwd_mega, dim3(grid), dim3(NTHREADS), LDS_BYTES, stream, a);
    }
#endif
}
```

```cpp
#include <hip/hip_runtime.h>
#include <hip/hip_cooperative_groups.h>
#include <cstdio>
#include <cstdint>
namespace cg = cooperative_groups;
namespace pg8 {
#define PG8_LAS __attribute__((address_space(3)))
typedef unsigned short bf16_t;
typedef short bf16x8 __attribute__((ext_vector_type(8)));
typedef float f32x4 __attribute__((ext_vector_type(4)));
typedef unsigned u32x4 __attribute__((ext_vector_type(4)));
constexpr int BM = 256, BK = 64, HALF = 128, HTB = HALF * BK * 2  , STAGE_BYTES = 8 * HTB, NXCD = 8, WGM = 8;

__host__ __device__ __forceinline__ int lds_byte(int r, int c) { const int st = (r >> 4) * 2 + (c >> 5), rr = r & 15, cc = c & 31, ob = rr * 64 + cc * 2; return st * 1024 + (ob ^ (((ob >> 9) & 1) << 5)); }
__host__ __device__ __forceinline__ void stage_rc(int b, int& R, int& C) { const int st = b / 1024, sb = b % 1024, swz = sb ^ (((sb >> 9) & 1) << 5); R = (st >> 1) * 16 + swz / 64; C = (st & 1) * 32 + (swz % 64) / 2; }
__host__ __device__ __forceinline__ int perm32(int rho) { const int n = rho >> 4, i = rho & 15; return 8 * (i >> 2) + 4 * n + (i & 3); }

struct Unit { int pm, pn; };
struct Gemm { const bf16_t* A; const bf16_t* Bt; int M, N, K; };

struct StaticOrder {
    int nM, nN, nwg, G, c;
    __host__ __device__ void init(int M, int N, int G_, int c_) { nM = M / BM; nN = N / BM; nwg = nM * nN; G = G_; c = c_; }
    __host__ __device__ bool next(int i, Unit& u) const {
        const long L = (long)i * G + c; if (L >= nwg) return false;
        int wgid = (int)L; { const int q = nwg / NXCD, r = nwg % NXCD, xcd = wgid % NXCD, off = wgid / NXCD; wgid = (xcd < r ? xcd * (q + 1) : r * (q + 1) + (xcd - r) * q) + off; }
        const int nig = WGM * nN, gid = wgid / nig, fm = gid * WGM, gsz = (nM - fm) < WGM ? (nM - fm) : WGM;
        u.pm = fm + ((wgid % nig) % gsz); u.pn = (wgid % nig) / gsz; return true;
    }
    __device__ __forceinline__ void a_ready(const Unit&) const {}
    __device__ __forceinline__ void done(const Unit&) const {}
};

template <int REP> struct RepOrder : StaticOrder {
    __host__ __device__ bool next(int i, Unit& u) const {
        if constexpr (REP > 1) { const int per = (nwg - c + G - 1) / G; if (i >= per * REP) return false; i %= per; }
        return StaticOrder::next(i, u);
    }
};
__device__ __forceinline__ unsigned cvt_pk_bf16(float lo, float hi) { unsigned r; asm volatile("v_cvt_pk_bf16_f32 %0, %1, %2" : "=v"(r) : "v"(lo), "v"(hi)); return r; }

__device__ __forceinline__ float sigmoidf_(float v) { return __builtin_amdgcn_rcpf(1.0f + __expf(-v)); }
struct EpiIn {
    static constexpr bool PERM = true, AFTER_DRAIN = false;
    bf16_t* P; const float* bias; const float* rstd; size_t bufstride;
    __device__ __forceinline__ void operator()(const f32x4 (&acc)[2][2][4][2], const Unit& u, int wr, int wc, int fr, int fq) const {
        const int row0 = u.pm * BM + wr * 64 + fr;
        const int cb = u.pn * BM + wc * 32 + 8 * fq;
        f32x4 bv[2][2];
#pragma unroll
        for (int bj = 0; bj < 2; ++bj)
#pragma unroll
            for (int n = 0; n < 2; ++n) bv[bj][n] = *(const f32x4*)(bias + cb + bj * HALF + 4 * n);
        if (u.pn < 4) {
            bf16_t* base = P + (128 * u.pn + wc * 32 + 8 * fq);
#pragma unroll
            for (int ai = 0; ai < 2; ++ai)
#pragma unroll
                for (int m = 0; m < 4; ++m) {
                    const int row = row0 + ai * HALF + m * 16; const float rs = rstd[row];
                    f32x4 a0 = acc[ai][0][m][0] * rs + bv[0][0], a1 = acc[ai][0][m][1] * rs + bv[0][1];
                    f32x4 b0 = acc[ai][1][m][0] * rs + bv[1][0], b1 = acc[ai][1][m][1] * rs + bv[1][1];
#pragma unroll
                    for (int j = 0; j < 4; ++j) { a0[j] *= sigmoidf_(b0[j]); a1[j] *= sigmoidf_(b1[j]); }
                    u32x4 w; w.x = cvt_pk_bf16(a0[0], a0[1]); w.y = cvt_pk_bf16(a0[2], a0[3]); w.z = cvt_pk_bf16(a1[0], a1[1]); w.w = cvt_pk_bf16(a1[2], a1[3]);
                    *(u32x4*)(base + (size_t)row * 512) = w;
                }
        } else {
            const int t = (u.pn - 4) >> 1;
            bf16_t* base = P + (size_t)(t + 1) * bufstride + ((u.pn - 4) & 1) * 256 + wc * 32 + 8 * fq;
            const bool gate = (t == 0) || (t == 4); const float sc = (t == 1) ? 0.125f : 1.0f;
#pragma unroll
            for (int ai = 0; ai < 2; ++ai)
#pragma unroll
                for (int m = 0; m < 4; ++m) {
                    const int row = row0 + ai * HALF + m * 16; const float rs = rstd[row];
#pragma unroll
                    for (int bj = 0; bj < 2; ++bj) {
                        f32x4 v0 = acc[ai][bj][m][0] * rs + bv[bj][0], v1 = acc[ai][bj][m][1] * rs + bv[bj][1];
                        if (gate) {
#pragma unroll
                            for (int j = 0; j < 4; ++j) { v0[j] *= sigmoidf_(v0[j]); v1[j] *= sigmoidf_(v1[j]); }
                        }
                        v0 = v0 * sc; v1 = v1 * sc;
                        u32x4 w; w.x = cvt_pk_bf16(v0[0], v0[1]); w.y = cvt_pk_bf16(v0[2], v0[3]); w.z = cvt_pk_bf16(v1[0], v1[1]); w.w = cvt_pk_bf16(v1[2], v1[3]);
                        *(u32x4*)(base + (size_t)row * 512 + bj * HALF) = w;
                    }
                }
        }
    }
};
struct EpiOut {
    static constexpr bool PERM = true, AFTER_DRAIN = false;
    const float* x; float* out; float* sspart;
    __device__ __forceinline__ void operator()(const f32x4 (&acc)[2][2][4][2], const Unit& u, int wr, int wc, int fr, int fq) const {
        const int row0 = u.pm * BM + wr * 64 + fr;
        const int col0 = u.pn * BM + wc * 32 + 8 * fq;
#pragma unroll
        for (int ai = 0; ai < 2; ++ai)
#pragma unroll
            for (int m = 0; m < 4; ++m) {
                const int row = row0 + ai * HALF + m * 16; float ss = 0.f;
#pragma unroll
                for (int bj = 0; bj < 2; ++bj) {
                    const size_t off = (size_t)row * 1024 + col0 + bj * HALF;
                    const f32x4 x0 = *(const f32x4*)(x + off), x1 = *(const f32x4*)(x + off + 4);
                    const f32x4 h0 = x0 + acc[ai][bj][m][0], h1 = x1 + acc[ai][bj][m][1];
                    *(f32x4*)(out + off) = h0; *(f32x4*)(out + off + 4) = h1;
                    ss += (h0[0] * h0[0] + h0[1] * h0[1]) + (h0[2] * h0[2] + h0[3] * h0[3]) + (h1[0] * h1[0] + h1[1] * h1[1]) + (h1[2] * h1[2] + h1[3] * h1[3]);
                }
                ss += __shfl_xor(ss, 16); ss += __shfl_xor(ss, 32);
                if (fq == 0) sspart[(size_t)row * 16 + u.pn * 4 + wc] = ss;
            }
    }
};

template <class Epi, class Sched, bool ALIGN_EPI = false, bool SP2 = false>
__device__ __forceinline__ void gemm_phase(PG8_LAS unsigned char* lds, const Gemm g, const Sched& S, const Epi& E) {
    const int tid = threadIdx.x, wid = __builtin_amdgcn_readfirstlane(tid >> 6), lane = tid & 63, wr = wid >> 2, wc = wid & 3, fr = lane & 15, fq = lane >> 4;
    const int K = g.K, nt = K / BK;
    unsigned voffA[2], voffB[2];
#pragma unroll
    for (int i = 0; i < 2; ++i) { int R, C; stage_rc(tid * 16 + i * 8192, R, C); const int Rb = Epi::PERM ? ((R & ~31) + perm32(R & 31)) : R;
        voffA[i] = (unsigned)(R * K + C) * 2u; voffB[i] = (unsigned)(Rb * K + C) * 2u; }
    const size_t kstep = (size_t)(BK * 2);
    const size_t hstep = (size_t)HALF * K * 2;
    const size_t tstep = 2 * hstep;
    const unsigned ldsw = (unsigned)wid * 1024u;
    const int aoff = lds_byte(wr * 64 + fr, fq * 8), boff = lds_byte(wc * 32 + fr, fq * 8);
#define PG8_SA(b, h) (((b) * 2 + (h)) * HTB)
#define PG8_SB(b, h) ((4 + (b) * 2 + (h)) * HTB)
#define PG8_STAGE(bufoff, gbase, voff) do { _Pragma("unroll") for (int _i = 0; _i < 2; ++_i) \
        __builtin_amdgcn_global_load_lds((const unsigned*)((const char*)(gbase) + (voff)[_i]), (PG8_LAS unsigned*)(lds + (bufoff) + ldsw + _i * 8192), 16, 0, 0); } while (0)
#define PG8_LDA(dst, b, h) do { _Pragma("unroll") for (int m = 0; m < 4; ++m) _Pragma("unroll") for (int k = 0; k < 2; ++k) dst[m][k] = *(const PG8_LAS bf16x8*)(lds + PG8_SA(b, h) + aoff + m * 2048 + k * 1024); } while (0)
#define PG8_LDB(dst, b, h) do { _Pragma("unroll") for (int n = 0; n < 2; ++n) _Pragma("unroll") for (int k = 0; k < 2; ++k) dst[n][k] = *(const PG8_LAS bf16x8*)(lds + PG8_SB(b, h) + boff + n * 2048 + k * 1024); } while (0)
#define PG8_MMA(ai, bj, At, Bt) do { __builtin_amdgcn_s_setprio(1); _Pragma("unroll") for (int m = 0; m < 4; ++m) _Pragma("unroll") for (int n = 0; n < 2; ++n) _Pragma("unroll") for (int k = 0; k < 2; ++k) \
        acc[ai][bj][m][n] = __builtin_amdgcn_mfma_f32_16x16x32_bf16(Bt[n][k], At[m][k], acc[ai][bj][m][n], 0, 0, 0); __builtin_amdgcn_s_setprio(0); } while (0)
#define PG8_WAIT_V(n) asm volatile("s_waitcnt vmcnt(" #n ")" ::: "memory")
#define PG8_WAIT_L(n) asm volatile("s_waitcnt lgkmcnt(" #n ")" ::: "memory")
#define PG8_BAR __builtin_amdgcn_s_barrier()
#define PG8_SCHED __builtin_amdgcn_sched_barrier(0)
    Unit cur, nxt; int ui = 0;
    if (!S.next(0, cur)) return;
    f32x4 acc[2][2][4][2];
#pragma unroll
    for (int a = 0; a < 2; ++a)
#pragma unroll
        for (int b = 0; b < 2; ++b)
#pragma unroll
            for (int m = 0; m < 4; ++m)
#pragma unroll
                for (int n = 0; n < 2; ++n) acc[a][b][m][n] = (f32x4){0.f, 0.f, 0.f, 0.f};
    bf16x8 At[4][2], B0[2][2], B1[2][2];
    const char* cA = (const char*)g.A + (size_t)cur.pm * tstep; const char* cB = (const char*)g.Bt + (size_t)cur.pn * tstep;
    S.a_ready(cur);
    if constexpr (SP2) {
        PG8_STAGE(PG8_SB(0, 0), cB, voffB); PG8_STAGE(PG8_SB(0, 1), cB + hstep, voffB); PG8_STAGE(PG8_SA(0, 0), cA, voffA); PG8_STAGE(PG8_SA(0, 1), cA + hstep, voffA);
        if (wr == 1) PG8_BAR;
        PG8_WAIT_V(2); PG8_BAR;
        PG8_STAGE(PG8_SB(1, 0), cB + kstep, voffB); PG8_STAGE(PG8_SA(1, 0), cA + kstep, voffA); PG8_STAGE(PG8_SB(1, 1), cB + hstep + kstep, voffB);
        PG8_WAIT_V(6); PG8_BAR;
    } else {
        PG8_STAGE(PG8_SB(0, 0), cB, voffB); PG8_STAGE(PG8_SA(0, 0), cA, voffA); PG8_STAGE(PG8_SB(0, 1), cB + hstep, voffB); PG8_STAGE(PG8_SA(0, 1), cA + hstep, voffA);
        if (wr == 1) PG8_BAR;
        PG8_WAIT_V(4); PG8_BAR;
        PG8_STAGE(PG8_SB(1, 0), cB + kstep, voffB); PG8_STAGE(PG8_SA(1, 0), cA + kstep, voffA); PG8_STAGE(PG8_SB(1, 1), cB + hstep + kstep, voffB);
        PG8_WAIT_V(6); PG8_BAR;
    }
    for (;;) {
        const bool has_next = S.next(ui + 1, nxt);
        const char* nA = has_next ? (const char*)g.A + (size_t)nxt.pm * tstep : cA; const char* nB = has_next ? (const char*)g.Bt + (size_t)nxt.pn * tstep : cB;
        for (int t = 0; t < nt; t += 2) {
            const bool last = (t == nt - 2);
            const char* a1 = cA + (size_t)(t + 1) * kstep;
            const char* a2 = last ? nA : cA + (size_t)(t + 2) * kstep; const char* b2 = last ? nB : cB + (size_t)(t + 2) * kstep;
            const char* a3 = a2 + kstep; const char* b3 = b2 + kstep;
            if (last && has_next) S.a_ready(nxt);
            if constexpr (SP2) {
            PG8_LDB(B0, 0, 0); PG8_LDB(B1, 0, 1); PG8_SCHED; PG8_LDA(At, 0, 0); PG8_STAGE(PG8_SA(1, 1), a1 + hstep, voffA);
            PG8_WAIT_V(8); PG8_WAIT_L(0); PG8_BAR; PG8_MMA(0, 0, At, B0); PG8_MMA(0, 1, At, B1); PG8_BAR; PG8_SCHED;
            PG8_LDA(At, 0, 1); PG8_STAGE(PG8_SB(0, 0), b2, voffB); PG8_STAGE(PG8_SB(0, 1), b2 + hstep, voffB); PG8_STAGE(PG8_SA(0, 0), a2, voffA);
            PG8_WAIT_V(8); PG8_WAIT_L(0); PG8_BAR; PG8_MMA(1, 0, At, B0); PG8_MMA(1, 1, At, B1); PG8_BAR; PG8_SCHED;
            PG8_LDB(B0, 1, 0); PG8_LDB(B1, 1, 1); PG8_SCHED; PG8_LDA(At, 1, 0); PG8_STAGE(PG8_SA(0, 1), a2 + hstep, voffA);
            PG8_WAIT_V(8); PG8_WAIT_L(0); PG8_BAR; PG8_MMA(0, 0, At, B0); PG8_MMA(0, 1, At, B1); PG8_BAR; PG8_SCHED;
            PG8_LDA(At, 1, 1); PG8_STAGE(PG8_SB(1, 0), b3, voffB); PG8_STAGE(PG8_SB(1, 1), b3 + hstep, voffB); PG8_STAGE(PG8_SA(1, 0), a3, voffA);
            PG8_WAIT_V(8); PG8_WAIT_L(0); PG8_BAR; PG8_MMA(1, 0, At, B0); PG8_MMA(1, 1, At, B1); PG8_BAR; PG8_SCHED;
            } else {
            PG8_LDB(B0, 0, 0); PG8_SCHED; PG8_LDA(At, 0, 0); PG8_STAGE(PG8_SA(1, 1), a1 + hstep, voffA);
            PG8_WAIT_L(8); PG8_BAR; PG8_WAIT_L(0); PG8_MMA(0, 0, At, B0); PG8_BAR; PG8_SCHED;
            PG8_LDB(B1, 0, 1); PG8_STAGE(PG8_SB(0, 0), b2, voffB);
            PG8_BAR; PG8_WAIT_L(0); PG8_MMA(0, 1, At, B1); PG8_BAR;
            PG8_LDA(At, 0, 1); PG8_STAGE(PG8_SA(0, 0), a2, voffA);
            PG8_BAR; PG8_WAIT_L(0); PG8_MMA(1, 0, At, B0); PG8_BAR; PG8_SCHED;
            PG8_STAGE(PG8_SB(0, 1), b2 + hstep, voffB);
            PG8_WAIT_V(6); PG8_BAR; PG8_MMA(1, 1, At, B1); PG8_BAR;
            PG8_LDB(B0, 1, 0); PG8_SCHED; PG8_LDA(At, 1, 0); PG8_STAGE(PG8_SA(0, 1), a2 + hstep, voffA);
            PG8_WAIT_L(8); PG8_BAR; PG8_WAIT_L(0); PG8_MMA(0, 0, At, B0); PG8_BAR; PG8_SCHED;
            PG8_LDB(B1, 1, 1); PG8_STAGE(PG8_SB(1, 0), b3, voffB);
            PG8_BAR; PG8_WAIT_L(0); PG8_MMA(0, 1, At, B1); PG8_BAR;
            PG8_LDA(At, 1, 1); PG8_STAGE(PG8_SA(1, 0), a3, voffA);
            PG8_BAR; PG8_WAIT_L(0); PG8_MMA(1, 0, At, B0); PG8_BAR; PG8_SCHED;
            PG8_STAGE(PG8_SB(1, 1), b3 + hstep, voffB);
            PG8_WAIT_V(6); PG8_BAR; PG8_MMA(1, 1, At, B1); PG8_BAR;
            }
        }
        if constexpr (ALIGN_EPI) { if (wr == 0) PG8_BAR; }
        if constexpr (!Epi::AFTER_DRAIN) { E(acc, cur, wr, wc, fr, fq); S.done(cur); }
        if (!has_next) break;
#pragma unroll
        for (int a = 0; a < 2; ++a)
#pragma unroll
            for (int b = 0; b < 2; ++b)
#pragma unroll
                for (int m = 0; m < 4; ++m)
#pragma unroll
                    for (int n = 0; n < 2; ++n) acc[a][b][m][n] = (f32x4){0.f, 0.f, 0.f, 0.f};
        cur = nxt; cA = nA; cB = nB; ++ui;
        if constexpr (ALIGN_EPI) { if (wr == 1) PG8_BAR; }
    }
    PG8_WAIT_V(0);
    if constexpr (!ALIGN_EPI) { if (wr == 0) PG8_BAR; }
    PG8_BAR;
    if constexpr (Epi::AFTER_DRAIN) { E.fused(acc, cur, wr, wc, fr, fq, lds, wid, lane); S.done(cur); }
#undef PG8_SA
#undef PG8_SB
#undef PG8_STAGE
#undef PG8_LDA
#undef PG8_LDB
#undef PG8_MMA
#undef PG8_WAIT_V
#undef PG8_WAIT_L
#undef PG8_BAR
#undef PG8_SCHED
}
}

#ifndef MK_LAUNCHES
#define MK_LAUNCHES 1
#endif
#ifndef REP_P0
#define REP_P0 1
#endif
#ifndef REP_P1
#define REP_P1 1
#endif
#ifndef REP_P3
#define REP_P3 1
#endif
typedef unsigned short bf16;
typedef short bf16x8 __attribute__((ext_vector_type(8)));
typedef short s16x4 __attribute__((ext_vector_type(4)));
typedef float f32x4 __attribute__((ext_vector_type(4)));
typedef float f32x16 __attribute__((ext_vector_type(16)));
typedef unsigned u32x4 __attribute__((ext_vector_type(4)));
typedef unsigned u32x2 __attribute__((ext_vector_type(2)));
#define LASX __attribute__((address_space(3)))

constexpr int BATCH = 2, SEQ = 8192, D = 1024, M = BATCH * SEQ, NPROJ = 3584;
constexpr float EPS = 1e-6f;
constexpr size_t MiB = 1u << 20;
constexpr size_t WS_WIN = 1 * MiB, WS_WOUT = 9 * MiB, WS_PW = 11 * MiB, WS_BIAS = 12 * MiB, WS_RSTD = 12 * MiB + 65536, WS_SSP = 13 * MiB;
constexpr size_t WS_XB = 16 * MiB, WS_P = 48 * MiB, WS_Y = 144 * MiB, WS_END = 176 * MiB;
constexpr size_t PBUF = (size_t)M * 512;
constexpr int LDS_BYTES = 147456;
constexpr int NTHREADS = 512, NWAVES = 8;

__device__ __forceinline__ float bf_lo(unsigned u) { return __builtin_bit_cast(float, u << 16); }
__device__ __forceinline__ float bf_hi(unsigned u) { return __builtin_bit_cast(float, u & 0xffff0000u); }
__device__ __forceinline__ unsigned pkbf(float lo, float hi) { unsigned r; asm("v_cvt_pk_bf16_f32 %0, %1, %2" : "=v"(r) : "v"(lo), "v"(hi)); return r; }
__device__ __forceinline__ float wave_sum(float v) {
#pragma unroll
    for (int o = 1; o < 64; o <<= 1) v += __shfl_xor(v, o);
    return v;
}
#define LDS_WAIT() asm volatile("s_waitcnt lgkmcnt(0)" ::: "memory")

__device__ __forceinline__ int colmap(int n) {
    if (n >= 1024) return n;
    if (n < 512) return 256 * (n >> 7) + (n & 127);
    n -= 512; return 256 * (n >> 7) + 128 + (n & 127);
}
__device__ __forceinline__ void transpose_item(const float* __restrict__ W, const float* __restrict__ g, int K, int N, bf16* WT, int mode, float* scr, int item, int lane) {
    const int nblk = N / 32, kb = item / nblk, nb = item % nblk, k0 = 64 * kb, n0 = 32 * nb;
#pragma unroll 8
    for (int i = 0; i < 32; ++i) { const int kk = 2 * i + (lane >> 5); float v = W[(size_t)(k0 + kk) * N + n0 + (lane & 31)]; if (g) v *= g[k0 + kk]; scr[kk * 33 + (lane & 31)] = v; }
    LDS_WAIT();
    const int c = lane & 7; const int row_off = (mode == 1) ? colmap(n0) : n0;
#pragma unroll
    for (int j = 0; j < 4; ++j) { const int n = (lane >> 3) + 8 * j; const float* s = scr + (8 * c) * 33 + n;
        u32x4 o; o.x = pkbf(s[0 * 33], s[1 * 33]); o.y = pkbf(s[2 * 33], s[3 * 33]); o.z = pkbf(s[4 * 33], s[5 * 33]); o.w = pkbf(s[6 * 33], s[7 * 33]);
        if (mode == 2) {
            const int k8 = (k0 >> 3) + c, T = nb, ks = k8 >> 1, ln = n + 32 * (k8 & 1);
            *(u32x4*)(WT + ((size_t)(T * (K >> 4) + ks) * 64 + ln) * 8) = o;
        } else *(u32x4*)(WT + (size_t)(row_off + n) * K + k0 + 8 * c) = o; }
    LDS_WAIT();
}

struct Args { const float* in[15]; float* out; unsigned char* ws; int ph_lo, ph_hi; int pad0, pad1; };

__device__ __forceinline__ void p0_prologue(unsigned char* lds, const Args& a, int G) {
    const int tid = threadIdx.x, lane = tid & 63, wave = tid >> 6;
    const float* x = a.in[0]; const float* ln_g = a.in[1]; const float* w_in = a.in[2]; const float* b_in = a.in[3];
    const float* pw_w = a.in[8]; const float* w_out = a.in[13];
    bf16* Wt_in = (bf16*)(a.ws + WS_WIN); bf16* Wt_out = (bf16*)(a.ws + WS_WOUT); bf16* Wt_pw = (bf16*)(a.ws + WS_PW);
    float* biasp = (float*)(a.ws + WS_BIAS); float* rstd = (float*)(a.ws + WS_RSTD); bf16* XB = (bf16*)(a.ws + WS_XB);
    float* scr = (float*)(lds + wave * 16384);
    const int gw = blockIdx.x * NWAVES + wave, NGW = G * NWAVES;
    constexpr int I_IN = (D / 64) * (NPROJ / 32), I_OUT = (D / 64) * (D / 32), I_PW = (512 / 64) * (512 / 32);
    for (int it = gw; it < I_IN + I_OUT + I_PW; it += NGW) {
        int r = it;
        if (r < I_IN) { transpose_item(w_in, ln_g, D, NPROJ, Wt_in, 1, scr, r, lane); continue; } r -= I_IN;
        if (r < I_OUT) { transpose_item(w_out, nullptr, D, D, Wt_out, 0, scr, r, lane); continue; } r -= I_OUT;
        transpose_item(pw_w, nullptr, 512, 512, Wt_pw, 2, scr, r, lane);
    }
    for (int n = blockIdx.x * NTHREADS + tid; n < NPROJ; n += G * NTHREADS) biasp[colmap(n)] = b_in[n];
    for (int m = gw; m < M; m += NGW) {
        const f32x4* xr = (const f32x4*)(x + (size_t)m * D) + lane;
        f32x4 v[4]; float s = 0.f;
#pragma unroll
        for (int j = 0; j < 4; ++j) { v[j] = xr[64 * j]; s += (v[j].x * v[j].x + v[j].y * v[j].y) + (v[j].z * v[j].z + v[j].w * v[j].w); }
        s = wave_sum(s);
        if (lane == 0) rstd[m] = 1.0f / sqrtf(s * (1.0f / D) + EPS);
        u32x2* o8 = (u32x2*)(XB + (size_t)m * D) + lane;
#pragma unroll
        for (int j = 0; j < 4; ++j) { u32x2 o; o.x = pkbf(v[j].x, v[j].y); o.y = pkbf(v[j].z, v[j].w); o8[64 * j] = o; }
    }
}

constexpr int CV_W_PITCH = 144, CV_W_BYTES = 512 * CV_W_PITCH;
constexpr int CV_VN_OFF = CV_W_BYTES, CV_VN_PITCH = 1040;
static_assert(CV_VN_OFF + 32 * CV_VN_PITCH <= LDS_BYTES && 62 * 1024 <= CV_W_BYTES, "conv LDS map");

__device__ __forceinline__ void conv_unit(unsigned char* lds, int unit, const bf16* __restrict__ U, const bf16* __restrict__ ZC, const float* __restrict__ dw_w, const float* __restrict__ dw_b,
                                          const float* __restrict__ cln_g, const float* __restrict__ cln_b, const bf16* __restrict__ pw_t, const float* __restrict__ pw_b,
                                          const float* __restrict__ gn_g, bf16* __restrict__ Y) {
    int tid = threadIdx.x; asm volatile("" : "+v"(tid));
    const int lane = tid & 63, w = __builtin_amdgcn_readfirstlane(tid >> 6);
    const int b = unit >> 8, tok0 = (unit & 255) * 32;
    const size_t rowbase = (size_t)b * SEQ;
    {
        u32x4 hv[8];
#pragma unroll
        for (int i = 0; i < 8; ++i) {
            const int idx = tid + i * NTHREADS, row = idx >> 6, ch = idx & 63, t = tok0 - 15 + row;
            const int tc = min(max(t, 0), SEQ - 1);
            hv[i] = *(const u32x4*)(U + (rowbase + tc) * 512 + ch * 8);
            if (t < 0 || t >= SEQ) hv[i] = (u32x4){0u, 0u, 0u, 0u};
        }
#pragma unroll
        for (int i = 0; i < 8; ++i) { const int idx = tid + i * NTHREADS, row = idx >> 6, ch = idx & 63; if (row < 62) *(u32x4*)(lds + row * 1024 + ch * 16) = hv[i]; }
    }
    const int cp = tid & 255, th = tid >> 8;
    typedef float f32x2 __attribute__((ext_vector_type(2)));
    f32x2 wv[31];
#pragma unroll
    for (int j = 0; j < 31; ++j) wv[j] = *(const f32x2*)(dw_w + j * 512 + 2 * cp);
    const f32x2 bb = *(const f32x2*)(dw_b + 2 * cp);
    __syncthreads();
    {
#pragma unroll 1
        for (int hf = 0; hf < 2; ++hf) {
            f32x2 uv[38];
            const unsigned char* up = lds + (16 * th + 8 * hf) * 1024 + cp * 4;
#pragma unroll
            for (int i = 0; i < 38; ++i) { const unsigned uu = *(const unsigned*)(up + i * 1024); uv[i] = (f32x2){bf_lo(uu), bf_hi(uu)}; }
            unsigned char* vp = lds + CV_VN_OFF + (16 * th + 8 * hf) * CV_VN_PITCH + cp * 4;
#pragma unroll
            for (int o = 0; o < 8; ++o) {
                f32x2 acc2 = bb;
#pragma unroll
                for (int j = 0; j < 31; ++j) acc2 = __builtin_elementwise_fma(wv[j], uv[o + j], acc2);
                *(unsigned*)(vp + o * CV_VN_PITCH) = pkbf(acc2.x, acc2.y);
                if (o & 1) __builtin_amdgcn_sched_barrier(0);
            }
        }
    }
    __syncthreads();
    {
        const f32x4 g0 = *(const f32x4*)(cln_g + 8 * lane), g1 = *(const f32x4*)(cln_g + 8 * lane + 4);
        const f32x4 c0 = *(const f32x4*)(cln_b + 8 * lane), c1 = *(const f32x4*)(cln_b + 8 * lane + 4);
#pragma unroll
        for (int tt = 0; tt < 4; ++tt) {
            unsigned char* p = lds + CV_VN_OFF + (4 * w + tt) * CV_VN_PITCH + lane * 16;
            const u32x4 raw = *(const u32x4*)p;
            float v[8] = {bf_lo(raw.x), bf_hi(raw.x), bf_lo(raw.y), bf_hi(raw.y), bf_lo(raw.z), bf_hi(raw.z), bf_lo(raw.w), bf_hi(raw.w)};
            float s = 0.f;
#pragma unroll
            for (int e = 0; e < 8; ++e) s += v[e];
            const float mean = wave_sum(s) * (1.0f / 512.0f);
            float q = 0.f;
#pragma unroll
            for (int e = 0; e < 8; ++e) { v[e] -= mean; q += v[e] * v[e]; }
            const float rstd = 1.0f / sqrtf(wave_sum(q) * (1.0f / 512.0f) + EPS);
            const float gg[8] = {g0[0], g0[1], g0[2], g0[3], g1[0], g1[1], g1[2], g1[3]};
            const float cc[8] = {c0[0], c0[1], c0[2], c0[3], c1[0], c1[1], c1[2], c1[3]};
#pragma unroll
            for (int e = 0; e < 8; ++e) { const float n = v[e] * rstd * gg[e] + cc[e]; v[e] = n * pg8::sigmoidf_(n); }
            u32x4 o; o.x = pkbf(v[0], v[1]); o.y = pkbf(v[2], v[3]); o.z = pkbf(v[4], v[5]); o.w = pkbf(v[6], v[7]);
            *(u32x4*)p = o;
        }
    }
    __syncthreads();
    const int r32 = lane & 31, h2 = lane >> 5;
    f32x16 acc[2];
#pragma unroll
    for (int a = 0; a < 2; ++a)
#pragma unroll
        for (int e = 0; e < 16; ++e) acc[a][e] = 0.f;
    {
        const unsigned char* wp0 = (const unsigned char*)pw_t + (size_t)(2 * w) * 32768 + lane * 16;
        const unsigned char* wp1 = wp0 + 32768;
        const unsigned char* bp = lds + CV_VN_OFF + r32 * CV_VN_PITCH + 16 * h2;
        u32x4 wA[8], wB[8];
#define CV_LD(dst, off) do { _Pragma("unroll") for (int ss = 0; ss < 4; ++ss) { dst[2 * ss] = *(const u32x4*)(wp0 + (off) + ss * 1024); dst[2 * ss + 1] = *(const u32x4*)(wp1 + (off) + ss * 1024); } } while (0)
#define CV_MM(src, off) do { _Pragma("unroll") for (int ss = 0; ss < 4; ++ss) { const bf16x8 bfr = *(const bf16x8*)(bp + (off) + ss * 32); \
            acc[0] = __builtin_amdgcn_mfma_f32_32x32x16_bf16(__builtin_bit_cast(bf16x8, src[2 * ss]), bfr, acc[0], 0, 0, 0); \
            acc[1] = __builtin_amdgcn_mfma_f32_32x32x16_bf16(__builtin_bit_cast(bf16x8, src[2 * ss + 1]), bfr, acc[1], 0, 0, 0); } } while (0)
        CV_LD(wA, 0);
#pragma unroll 1
        for (int g2 = 0; g2 < 4; ++g2) {
            CV_LD(wB, 4096);
            CV_MM(wA, 0);
            wp0 += 8192; wp1 += 8192;
            if (g2 < 3) CV_LD(wA, 0);
            CV_MM(wB, 128);
            bp += 256;
        }
#undef CV_LD
#undef CV_MM
    }
    const size_t row = rowbase + tok0 + r32;
    float ss = 0.f;
#pragma unroll
    for (int a = 0; a < 2; ++a)
#pragma unroll
        for (int rg = 0; rg < 4; ++rg) {
            const f32x4 pb = *(const f32x4*)(pw_b + 64 * w + 32 * a + 8 * rg + 4 * h2);
#pragma unroll
            for (int j = 0; j < 4; ++j) { const float v = acc[a][4 * rg + j] + pb[j]; acc[a][4 * rg + j] = v; ss += v * v; }
        }
    ss += __shfl_xor(ss, 32);
    const float rstd = 1.0f / sqrtf(ss * (1.0f / 64.0f) + EPS);
#pragma unroll
    for (int a = 0; a < 2; ++a)
#pragma unroll
        for (int rg = 0; rg < 4; ++rg) {
            const int oc0 = 64 * w + 32 * a + 8 * rg + 4 * h2;
            const f32x4 g = *(const f32x4*)(gn_g + oc0);
            const u32x2 z = *(const u32x2*)(ZC + row * 512 + oc0);
            u32x2 o;
            o.x = pkbf(acc[a][4 * rg + 0] * rstd * g[0] * bf_lo(z.x), acc[a][4 * rg + 1] * rstd * g[1] * bf_hi(z.x));
            o.y = pkbf(acc[a][4 * rg + 2] * rstd * g[2] * bf_lo(z.y), acc[a][4 * rg + 3] * rstd * g[3] * bf_hi(z.y));
            *(u32x2*)(Y + row * 1024 + oc0) = o;
        }
    __syncthreads();
}

constexpr int AT_RPB_OFF = 2 * 8 * 64 * 128;
static_assert(AT_RPB_OFF + 2 * 465 * 4 <= LDS_BYTES - 16, "attention LDS map");
__device__ __forceinline__ s16x4 vtr(const unsigned char* p) {
    typedef short v4i16_t __attribute__((ext_vector_type(4)));
    return __builtin_bit_cast(s16x4, __builtin_amdgcn_ds_read_tr16_b64_v4i16((LASX v4i16_t*)p));
}
__device__ __forceinline__ void attn_group(unsigned char* lds, int grp, const bf16* __restrict__ Q, const bf16* __restrict__ K, const bf16* __restrict__ V, const bf16* __restrict__ ZA,
                                           const float* __restrict__ rpb, const float* __restrict__ gn_g, bf16* __restrict__ Y) {
    int tid = threadIdx.x; asm volatile("" : "+v"(tid));
    const int lane = tid & 63, w = __builtin_amdgcn_readfirstlane(tid >> 6);
    const int b = grp >> 7, hp = (grp >> 5) & 3, r0 = (grp & 31) * 4;
    const size_t rowbase = (size_t)b * SEQ;
    const bf16* Vh = V + hp * 128;
    {
        const int rs0 = min(max(r0 - 4, 0), 120);
#pragma unroll
        for (int hb = 0; hb < 2; ++hb) {
            u32x4 vv[8];
#pragma unroll
            for (int k = 0; k < 8; ++k) {
                const int idx = tid + (hb * 8 + k) * NTHREADS, tr = idx >> 4, c16 = idx & 15, i = tr >> 6, tok = tr & 63;
                vv[k] = *(const u32x4*)(Vh + (rowbase + (size_t)(rs0 + i) * 64 + tok) * 512 + c16 * 8);
            }
#pragma unroll
            for (int k = 0; k < 8; ++k) {
                const int idx = tid + (hb * 8 + k) * NTHREADS, tr = idx >> 4, c16 = idx & 15, i = tr >> 6, tok = tr & 63, head = c16 >> 3, ch = c16 & 7;
                *(u32x4*)(lds + head * 65536 + ((rs0 + i) & 7) * 8192 + tok * 128 + (((ch >> 1) ^ ((tok >> 1) & 3)) << 5) + ((ch & 1) << 4)) = vv[k];
            }
        }
        for (int idx = tid; idx < 930; idx += NTHREADS) ((float*)(lds + AT_RPB_OFF))[idx] = rpb[hp * 930 + idx];
    }
    __syncthreads();
    const int hl = w >> 2, c = w & 3, h = 2 * hp + hl;
    const int wc0 = (c == 0) ? 0 : (c == 1) ? 8 : (c == 2) ? 24 : 32;
    const int l16 = lane & 15, g = lane >> 4;
    const int wq = 16 * c + l16, cs = min(max(wq - 8, 0), 48);
    const float* tbl = (const float*)(lds + AT_RPB_OFF) + hl * 465;
    const unsigned char* vb = lds + hl * 65536;
    const int qq = l16 >> 2, pp = l16 & 3;
    const int key0 = wc0 + 4 * g + qq, sw = (key0 >> 1) & 3;
#pragma unroll 1
    for (int kstep = 0; kstep < 4; ++kstep) {
        const int r = r0 + kstep, rs = min(max(r - 4, 0), 120), rsn = min(max(r - 3, 0), 120);
        const bool pf = (kstep < 3) && (rsn != rs);
        u32x4 nv[2];
        if (pf) {
#pragma unroll
            for (int p = 0; p < 2; ++p) { const int idx = tid + p * NTHREADS, tok = idx >> 4, c16 = idx & 15; nv[p] = *(const u32x4*)(Vh + (rowbase + (size_t)(rsn + 7) * 64 + tok) * 512 + c16 * 8); }
        }
        const size_t tq = rowbase + (size_t)r * 64 + 16 * c + l16;
        const bf16x8 qf0 = *(const bf16x8*)(Q + tq * 512 + h * 64 + 8 * g), qf1 = *(const bf16x8*)(Q + tq * 512 + h * 64 + 32 + 8 * g);
        f32x4 st[8][2];
#pragma unroll
        for (int i = 0; i < 8; ++i)
#pragma unroll
            for (int hh = 0; hh < 2; ++hh) {
                const bf16* kp = K + (rowbase + (size_t)(rs + i) * 64 + wc0 + 16 * hh + l16) * 512 + h * 64 + 8 * g;
                const bf16x8 k0 = *(const bf16x8*)kp, k1 = *(const bf16x8*)(kp + 32);
                f32x4 z = {0.f, 0.f, 0.f, 0.f};
                z = __builtin_amdgcn_mfma_f32_16x16x32_bf16(k0, qf0, z, 0, 0, 0);
                z = __builtin_amdgcn_mfma_f32_16x16x32_bf16(k1, qf1, z, 0, 0, 0);
                st[i][hh] = z;
            }
        float mx = -1e30f;
#pragma unroll
        for (int i = 0; i < 8; ++i) {
            const int rowoff = (rs + i - r + 7) * 31 - wq + 15;
#pragma unroll
            for (int hh = 0; hh < 2; ++hh)
#pragma unroll
                for (int j = 0; j < 4; ++j) {
                    const int kc = wc0 + 16 * hh + 4 * g + j;
                    const bool inw = (kc >= cs) && (kc < cs + 16);
                    const float bias = tbl[inw ? rowoff + kc : 0];
                    const float sv = inw ? st[i][hh][j] + bias : -1e30f;
                    st[i][hh][j] = sv; mx = fmaxf(mx, sv);
                }
        }
        mx = fmaxf(mx, __shfl_xor(mx, 16)); mx = fmaxf(mx, __shfl_xor(mx, 32));
        float sum = 0.f;
#pragma unroll
        for (int i = 0; i < 8; ++i)
#pragma unroll
            for (int hh = 0; hh < 2; ++hh)
#pragma unroll
                for (int j = 0; j < 4; ++j) { const float p = __builtin_amdgcn_exp2f((st[i][hh][j] - mx) * 1.4426950408889634f); st[i][hh][j] = p; sum += p; }
        sum += __shfl_xor(sum, 16); sum += __shfl_xor(sum, 32);
        f32x4 o[4];
#pragma unroll
        for (int ht = 0; ht < 4; ++ht) o[ht] = (f32x4){0.f, 0.f, 0.f, 0.f};
#pragma unroll
        for (int i = 0; i < 8; ++i) {
            u32x4 pw; pw.x = pkbf(st[i][0][0], st[i][0][1]); pw.y = pkbf(st[i][0][2], st[i][0][3]); pw.z = pkbf(st[i][1][0], st[i][1][1]); pw.w = pkbf(st[i][1][2], st[i][1][3]);
            const bf16x8 pf8 = __builtin_bit_cast(bf16x8, pw);
            const unsigned char* vrow = vb + ((rs + i) & 7) * 8192 + key0 * 128 + 8 * pp;
#pragma unroll
            for (int ht = 0; ht < 4; ++ht) {
                const unsigned char* a0 = vrow + ((ht ^ sw) << 5);
                const s16x4 lo = vtr(a0), hi = vtr(a0 + 16 * 128);
                const bf16x8 vf = __builtin_shufflevector(lo, hi, 0, 1, 2, 3, 4, 5, 6, 7);
                o[ht] = __builtin_amdgcn_mfma_f32_16x16x32_bf16(vf, pf8, o[ht], 0, 0, 0);
            }
        }
        const float inv = 1.0f / sum;
        float ss = 0.f;
#pragma unroll
        for (int ht = 0; ht < 4; ++ht)
#pragma unroll
            for (int j = 0; j < 4; ++j) { const float v = o[ht][j] * inv; o[ht][j] = v; ss += v * v; }
        ss += __shfl_xor(ss, 16); ss += __shfl_xor(ss, 32);
        const float rstd = 1.0f / sqrtf(ss * (1.0f / 64.0f) + EPS);
#pragma unroll
        for (int ht = 0; ht < 4; ++ht) {
            const int ch = h * 64 + 16 * ht + 4 * g;
            const f32x4 gg = *(const f32x4*)(gn_g + ch);
            const u32x2 z = *(const u32x2*)(ZA + tq * 512 + ch);
            u32x2 ov;
            ov.x = pkbf(o[ht][0] * rstd * gg[0] * bf_lo(z.x), o[ht][1] * rstd * gg[1] * bf_hi(z.x));
            ov.y = pkbf(o[ht][2] * rstd * gg[2] * bf_lo(z.y), o[ht][3] * rstd * gg[3] * bf_hi(z.y));
            *(u32x2*)(Y + tq * 1024 + 512 + ch) = ov;
        }
        __syncthreads();
        if (pf) {
#pragma unroll
            for (int p = 0; p < 2; ++p) { const int idx = tid + p * NTHREADS, tok = idx >> 4, c16 = idx & 15, head = c16 >> 3, ch = c16 & 7;
                *(u32x4*)(lds + head * 65536 + ((rsn + 7) & 7) * 8192 + tok * 128 + (((ch >> 1) ^ ((tok >> 1) & 3)) << 5) + ((ch & 1) << 4)) = nv[p]; }
            __syncthreads();
        }
    }
}

#define LAS __attribute__((address_space(3)))
#define XB_TMO      128
#define XB_XCNT(j)  (256  + 64 * (j))
#define XB_XSUB(j)  (1280 + 64 * (j))
#define XB_XGEN(j)  (2304 + 64 * (j))
#define XB_TOP      3328
#define XB_TOPGEN   3392
#define XCD_BAR_WORDS 3456
#define XB_SPIN_CAP (1u << 18)

__device__ __forceinline__ unsigned xb_ld(unsigned* p)              { return __hip_atomic_load(p, __ATOMIC_RELAXED, __HIP_MEMORY_SCOPE_AGENT); }
__device__ __forceinline__ unsigned xb_add(unsigned* p, unsigned v) { return __hip_atomic_fetch_add(p, v, __ATOMIC_RELAXED, __HIP_MEMORY_SCOPE_AGENT); }
__device__ __forceinline__ unsigned xb_xcc_id() { return (unsigned)__builtin_amdgcn_s_getreg((3 << 11) | 20) & 0xFu; }
#define XB_SPIN(cond, bar) do { unsigned _sp = 0; while (cond) { __builtin_amdgcn_s_sleep(1); \
    if ((++_sp & 255u) == 0u) { if (xb_ld(&(bar)[XB_TMO])) break; if (_sp > XB_SPIN_CAP) { atomicAdd(&(bar)[XB_TMO], 1u); break; } } } } while (0)

struct XcdBarrier {
    unsigned* bar; unsigned x;
    volatile LAS unsigned* st;
};

__device__ __forceinline__ XcdBarrier xcd_barrier_post(unsigned* bar, volatile LAS unsigned* st) {
    XcdBarrier b; b.bar = bar; b.x = xb_xcc_id(); b.st = st;
    if (threadIdx.x == 0) (void)xb_add(&bar[XB_XCNT(b.x)], 1u);
    return b;
}
__device__ __forceinline__ void xcd_barrier_complete(unsigned* bar, unsigned x, unsigned& nloc, unsigned& nx) {
    const unsigned G = gridDim.x * gridDim.y * gridDim.z;
    unsigned sum, cnt, mine, sp = 0u;
    for (;;) {
        sum = 0u; cnt = 0u; mine = 0u;
#pragma unroll
        for (unsigned j = 0; j < 16; ++j) { const unsigned c = xb_ld(&bar[XB_XCNT(j)]); sum += c; cnt += (c > 0u) ? 1u : 0u; mine = (j == x) ? c : mine; }
        if (sum == G) break;
        __builtin_amdgcn_s_sleep(1);
        if ((++sp & 255u) == 0u) { if (xb_ld(&bar[XB_TMO])) break; if (sp > XB_SPIN_CAP) { atomicAdd(&bar[XB_TMO], 1u); break; } }
    }
    nloc = mine > 0u ? mine : 1u; nx = cnt > 0u ? cnt : 1u;
}

__device__ __forceinline__ void xcd_barrier(const XcdBarrier& b) {
    asm volatile("s_waitcnt vmcnt(0)" ::: "memory");
    __syncthreads();
    if (threadIdx.x == 0) {
        unsigned* bar = b.bar;
        __builtin_amdgcn_s_waitcnt(0);
        unsigned nloc = b.st[0], nx = b.st[1];
        if (nloc == 0u) { xcd_barrier_complete(bar, b.x, nloc, nx); b.st[0] = nloc; b.st[1] = nx; }
        const unsigned old = xb_add(&bar[XB_XSUB(b.x)], 1u);
        const unsigned gen = old / nloc;
        if (old + 1u == (gen + 1u) * nloc) {
            __builtin_amdgcn_fence(__ATOMIC_RELEASE, "agent");
            asm volatile("s_waitcnt vmcnt(0)" ::: "memory");
            const unsigned og = xb_add(&bar[XB_TOP], 1u);
            const unsigned tg = og / nx;
            if (og + 1u == (tg + 1u) * nx) xb_add(&bar[XB_TOPGEN], 1u);
            else XB_SPIN(xb_ld(&bar[XB_TOPGEN]) == tg, bar);
            __builtin_amdgcn_fence(__ATOMIC_ACQUIRE, "agent");
            xb_add(&bar[XB_XGEN(b.x)], 1u);
            asm volatile("s_waitcnt vmcnt(0)" ::: "memory");
        } else {
            XB_SPIN(xb_ld(&bar[XB_XGEN(b.x)]) == gen, bar);
            __builtin_amdgcn_fence(__ATOMIC_ACQUIRE, "agent");
            asm volatile("s_waitcnt vmcnt(0)" ::: "memory");
        }
    }
    __syncthreads();
}

__global__ void __launch_bounds__(NTHREADS, 2) fwd_mega(Args a) {
    extern __shared__ __attribute__((aligned(16))) unsigned char lds[];
    cg::grid_group grid = cg::this_grid();
    volatile LAS unsigned* bst = (volatile LAS unsigned*)((LAS unsigned char*)lds + LDS_BYTES - 16);
    if (threadIdx.x < 4) bst[threadIdx.x] = 0u;
    __syncthreads();
    XcdBarrier bar = xcd_barrier_post((unsigned*)a.ws, bst);
    const int G = gridDim.x, tid = threadIdx.x, lane = tid & 63, wave = tid >> 6;
    const int lo = a.ph_lo, hi = a.ph_hi;
    unsigned char* ws = a.ws;
    bf16* P = (bf16*)(ws + WS_P); bf16* Yb = (bf16*)(ws + WS_Y);
#define IN(k) (lo <= (k) && (k) < hi)
#define SEAM(k) do { if (IN(k) && IN((k) + 1)) { if (lo < 0) grid.sync(); xcd_barrier(bar); } } while (0)
#ifndef SKIP_P0
    if (IN(0)) p0_prologue(lds, a, G);
#if REP_P0 > 1
    if (IN(0)) p0_prologue(lds, a, G);
#endif
#endif
    SEAM(0);
#ifndef SKIP_P1
    if (IN(1)) {
        pg8::Gemm g{(const pg8::bf16_t*)(ws + WS_XB), (const pg8::bf16_t*)(ws + WS_WIN), M, NPROJ, D};
        pg8::RepOrder<REP_P1> S; S.init(M, NPROJ, G, (int)blockIdx.x);
        pg8::EpiIn E{(pg8::bf16_t*)P, (const float*)(ws + WS_BIAS), (const float*)(ws + WS_RSTD), PBUF};
        pg8::gemm_phase<pg8::EpiIn, pg8::RepOrder<REP_P1>, true, true>((PG8_LAS unsigned char*)lds, g, S, E);
    }
#endif
    SEAM(1);
    if (IN(2)) {
        const int vcu = (G % 8 == 0) ? (int)(blockIdx.x % 8) * (G / 8) + (int)blockIdx.x / 8 : (int)blockIdx.x;
#ifndef REP_CONV
#define REP_CONV 1
#endif
#ifndef REP_ATTN
#define REP_ATTN 1
#endif
#ifndef SKIP_CONV
        for (int u = vcu; u < 512; u += G) {
            conv_unit(lds, u, P, P + PBUF, a.in[4], a.in[5], a.in[6], a.in[7], (const bf16*)(ws + WS_PW), a.in[9], a.in[11], Yb);
#if REP_CONV > 1
            conv_unit(lds, u, P, P + PBUF, a.in[4], a.in[5], a.in[6], a.in[7], (const bf16*)(ws + WS_PW), a.in[9], a.in[11], Yb);
#endif
        }
#endif
#ifndef SKIP_ATTN
        for (int u = vcu; u < 256; u += G) {
            attn_group(lds, u, P + 2 * PBUF, P + 3 * PBUF, P + 4 * PBUF, P + 5 * PBUF, a.in[10], a.in[12], Yb);
#if REP_ATTN > 1
            attn_group(lds, u, P + 2 * PBUF, P + 3 * PBUF, P + 4 * PBUF, P + 5 * PBUF, a.in[10], a.in[12], Yb);
#endif
        }
#endif
    }
    SEAM(2);
#ifndef SKIP_P3
    if (IN(3)) {
        pg8::Gemm g{(const pg8::bf16_t*)Yb, (const pg8::bf16_t*)(ws + WS_WOUT), M, D, D};
        pg8::RepOrder<REP_P3> S; S.init(M, D, G, (int)blockIdx.x);
        pg8::EpiOut E{a.in[0], a.out, (float*)(ws + WS_SSP)};
        pg8::gemm_phase<pg8::EpiOut, pg8::RepOrder<REP_P3>, true, true>((PG8_LAS unsigned char*)lds, g, S, E);
    }
#endif
    SEAM(3);
    if (IN(4)) {
        const float* ssp = (const float*)(ws + WS_SSP); const float* fg = a.in[14];
        f32x4 gv[4];
#pragma unroll
        for (int j = 0; j < 4; ++j) gv[j] = *((const f32x4*)fg + lane + 64 * j);
        for (int m = blockIdx.x * NWAVES + wave; m < M; m += G * NWAVES) {
            float s = (lane < 16) ? ssp[(size_t)m * 16 + lane] : 0.f;
            s = wave_sum(s);
            const float rstd = 1.0f / sqrtf(s * (1.0f / D) + EPS);
            f32x4* o = (f32x4*)(a.out + (size_t)m * D) + lane;
#pragma unroll
            for (int j = 0; j < 4; ++j) { f32x4 v = o[64 * j]; v = v * rstd * gv[j]; o[64 * j] = v; }
        }
    }
#undef IN
#undef SEAM
}

extern "C" void kernel_launch(void* const* d_in, const int* in_sizes, int n_in, void* d_out, int out_size, void* d_ws, size_t ws_size, hipStream_t stream) {
    static int grid = 0;
    if (grid == 0) {
        if (n_in != 15 || in_sizes[0] != M * D || out_size != M * D || ws_size < WS_END) { fprintf(stderr, "kernel_launch: unexpected shapes (n_in %d, in0 %d, out %d, ws %zu)\n", n_in, n_in > 0 ? in_sizes[0] : -1, out_size, ws_size); grid = -1; return; }
        int dev = 0, cus = 0, per_cu = 0;
        hipGetDevice(&dev);
        hipDeviceGetAttribute(&cus, hipDeviceAttributeMultiprocessorCount, dev);
        if (hipFuncSetAttribute((const void*)fwd_mega, hipFuncAttributeMaxDynamicSharedMemorySize, LDS_BYTES) != hipSuccess) { fprintf(stderr, "kernel_launch: hipFuncSetAttribute failed\n"); grid = -1; return; }
        if (hipOccupancyMaxActiveBlocksPerMultiprocessor(&per_cu, (const void*)fwd_mega, NTHREADS, LDS_BYTES) != hipSuccess || per_cu < 1) { fprintf(stderr, "kernel_launch: occupancy query says %d blocks per CU\n", per_cu); per_cu = 1; }
        (void)hipGetLastError();
        grid = cus * per_cu;
    }
    if (grid < 0) return;
    if (hipMemsetAsync(d_ws, 0, 16384, stream) != hipSuccess) { fprintf(stderr, "kernel_launch: hipMemsetAsync failed\n"); return; }
    Args a{};
    for (int i = 0; i < 15; ++i) a.in[i] = (const float*)d_in[i];
    a.out = (float*)d_out; a.ws = (unsigned char*)d_ws;
#if MK_LAUNCHES == 1
    a.ph_lo = 0; a.ph_hi = 5;
    void* args[] = {&a};
    hipError_t e = hipLaunchCooperativeKernel((const void*)fwd_mega, dim3(grid), dim3(NTHREADS), args, LDS_BYTES, stream);
    if (e != hipSuccess) fprintf(stderr, "kernel_launch: cooperative launch failed: %s (grid %d)\n", hipGetErrorString(e), grid);
#else
    for (int k = 0; k < 5; ++k) {
        a.ph_lo = k; a.ph_hi = k + 1;
        hipLaunchKernelGGL(fwd_mega, dim3(grid), dim3(NTHREADS), LDS_BYTES, stream, a);
    }
#endif
}
```
